# Optimizing an MI355X kernel written in HIP

```python
import math
import jax, jax.numpy as jnp
from jax import lax
import numpy as np

D_MODEL = 1024
BATCH = 16
SEQ = 2048
DEPTH = 2

MEM_LEN = 256
HEAD_DIM = 64
GMLP_GROUPS = 6
MOBA_HEADS = 6
MEM_HEADS = 4
D_GMLP = GMLP_GROUPS * HEAD_DIM
D_MOBA = MOBA_HEADS * HEAD_DIM
D_MEM = MEM_HEADS * HEAD_DIM
D_MIX = D_GMLP + D_MOBA + D_MEM
D_IN = 2 * D_GMLP + 3 * D_MOBA + D_MEM + D_MIX
GMLP_CHUNK = 128
MOBA_BLOCK = 256
MOBA_TOPK = 3
MOBA_Q_CHUNK = 32
REL_BUCKETS = 32
REL_MAX_DIST = 128
EPS = 1e-6
NEG = -1e30

kernel_name = "hybrid_gmlp_moba_memory_block"


def rmsnorm(x, g):
    xf = x.astype(jnp.float32)
    y = xf * lax.rsqrt(jnp.mean(xf * xf, axis=-1, keepdims=True) + EPS)
    return (y * g.astype(jnp.float32)).astype(x.dtype)


def t5_bucket(dist):
    dist = jnp.maximum(dist, 0)
    max_exact = REL_BUCKETS // 2
    df = jnp.maximum(dist, 1).astype(jnp.float32)
    large = max_exact + (jnp.log(df / max_exact) / math.log(REL_MAX_DIST / max_exact)
                         * (REL_BUCKETS - max_exact)).astype(jnp.int32)
    large = jnp.minimum(large, REL_BUCKETS - 1)
    return jnp.where(dist < max_exact, dist, large)


def to_heads(t, n_heads):
    b, s, _ = t.shape
    return t.reshape(b, s, n_heads, HEAD_DIM).transpose(0, 2, 1, 3)


def gmlp_branch(u, v, ln_g, ln_b, w_s, b_s):
    b, s, _ = u.shape
    nc = s // GMLP_CHUNK
    u = jax.nn.gelu(u)
    v = jax.nn.gelu(v).reshape(b, nc, GMLP_CHUNK, GMLP_GROUPS, HEAD_DIM)
    vf = v.astype(jnp.float32)
    mu = jnp.mean(vf, axis=-1, keepdims=True)
    var = jnp.mean(jnp.square(vf - mu), axis=-1, keepdims=True)
    vn = ((vf - mu) * lax.rsqrt(var + EPS) * ln_g.reshape(GMLP_GROUPS, HEAD_DIM)
          + ln_b.reshape(GMLP_GROUPS, HEAD_DIM)).astype(u.dtype)
    causal = jnp.tril(jnp.ones((GMLP_CHUNK, GMLP_CHUNK), dtype=w_s.dtype))
    w = w_s * causal[None]
    sv = jnp.einsum('gts,bcsgd->bctgd', w, vn) + b_s.T[None, None, :, :, None]
    return (u.reshape(b, nc, GMLP_CHUNK, GMLP_GROUPS, HEAD_DIM) * sv).reshape(b, s, D_GMLP)


def moba_branch(q, k, v, rel_bias):
    b, s, _ = q.shape
    h = MOBA_HEADS
    nb = -(-s // MOBA_BLOCK)
    pad = nb * MOBA_BLOCK - s
    k_sel = min(MOBA_TOPK, max(nb - 1, 1))
    qh = to_heads(q, h) * (HEAD_DIM ** -0.5)
    kh = jnp.pad(to_heads(k, h), ((0, 0), (0, 0), (0, pad), (0, 0)))
    vh = jnp.pad(to_heads(v, h), ((0, 0), (0, 0), (0, pad), (0, 0)))
    kb = kh.reshape(b, h, nb, MOBA_BLOCK, HEAD_DIM)
    vb = vh.reshape(b, h, nb, MOBA_BLOCK, HEAD_DIM)
    kmean = jnp.mean(kb.astype(jnp.float32), axis=3).astype(kb.dtype)
    n_qc = s // MOBA_Q_CHUNK
    qc = qh.reshape(b, h, n_qc, MOBA_Q_CHUNK, HEAD_DIM).transpose(2, 0, 1, 3, 4)
    table_t = rel_bias.T.astype(jnp.float32)
    bi = jnp.arange(b)[:, None, None, None]
    hi = jnp.arange(h)[None, :, None, None]
    blk_off = jnp.arange(MOBA_BLOCK)

    def step(args):
        c, qb = args
        q_pos = c * MOBA_Q_CHUNK + jnp.arange(MOBA_Q_CHUNK)
        blk = (c * MOBA_Q_CHUNK) // MOBA_BLOCK
        gs = jnp.einsum('bhqd,bhnd->bhqn', qb, kmean).astype(jnp.float32)
        gs = jnp.where(jnp.arange(nb) < blk, gs, NEG)
        _, sel = lax.top_k(gs, k_sel)
        valid = sel < blk
        kg = kb[bi, hi, sel]
        vg = vb[bi, hi, sel]
        l_past = jnp.einsum('bhqd,bhqnkd->bhqnk', qb, kg).astype(jnp.float32)
        past_pos = sel[..., None] * MOBA_BLOCK + blk_off
        past_bkt = t5_bucket(q_pos[None, None, :, None, None] - past_pos)
        l_past = l_past + table_t[hi[..., None], past_bkt]
        l_past = jnp.where(valid[..., None], l_past, NEG)
        k_own = lax.dynamic_index_in_dim(kb, blk, axis=2, keepdims=False)
        v_own = lax.dynamic_index_in_dim(vb, blk, axis=2, keepdims=False)
        own_pos = blk * MOBA_BLOCK + blk_off
        dist = q_pos[:, None] - own_pos[None, :]
        l_own = jnp.einsum('bhqd,bhkd->bhqk', qb, k_own).astype(jnp.float32)
        l_own = l_own + table_t[:, t5_bucket(dist)][None]
        l_own = jnp.where((dist >= 0)[None, None], l_own, NEG)
        logits = jnp.concatenate(
            [l_past.reshape(b, h, MOBA_Q_CHUNK, k_sel * MOBA_BLOCK), l_own], axis=-1)
        p = jax.nn.softmax(logits, axis=-1).astype(vb.dtype)
        p_past = p[..., :k_sel * MOBA_BLOCK].reshape(b, h, MOBA_Q_CHUNK, k_sel, MOBA_BLOCK)
        p_own = p[..., k_sel * MOBA_BLOCK:]
        return (jnp.einsum('bhqnk,bhqnkd->bhqd', p_past, vg)
                + jnp.einsum('bhqk,bhkd->bhqd', p_own, v_own))

    out = lax.map(step, (jnp.arange(n_qc), qc))
    return out.transpose(1, 0, 3, 2, 4).reshape(b, s, D_MOBA)


def memory_branch(q, mem_n, w_kv):
    b, s, _ = q.shape
    k, v = jnp.split(mem_n @ w_kv, 2, axis=-1)
    qh = to_heads(q, MEM_HEADS) * (HEAD_DIM ** -0.5)
    kh = to_heads(k, MEM_HEADS)
    vh = to_heads(v, MEM_HEADS)
    logits = jnp.einsum('bhqd,bhkd->bhqk', qh, kh).astype(jnp.float32)
    p = jax.nn.softmax(logits, axis=-1).astype(vh.dtype)
    o = jnp.einsum('bhqk,bhkd->bhqd', p, vh)
    return o.transpose(0, 2, 1, 3).reshape(b, s, D_MEM)


def setup_inputs(seed: int = 0) -> dict:
    key = jax.random.key(seed)
    ks = jax.random.split(key, 16)
    nrm = jax.random.normal
    f32 = jnp.float32
    return {
        "x": nrm(ks[0], (BATCH, SEQ, D_MODEL), f32),
        "mem": nrm(ks[1], (BATCH, MEM_LEN, D_MODEL), f32),
        "norm_g": 1.0 + 0.02 * nrm(ks[2], (DEPTH, D_MODEL), f32),
        "w_in": nrm(ks[3], (DEPTH, D_MODEL, D_IN), f32) * D_MODEL ** -0.5,
        "gmlp_ln_g": 1.0 + 0.02 * nrm(ks[4], (DEPTH, D_GMLP), f32),
        "gmlp_ln_b": 0.02 * nrm(ks[5], (DEPTH, D_GMLP), f32),
        "spatial_w": nrm(ks[6], (DEPTH, GMLP_GROUPS, GMLP_CHUNK, GMLP_CHUNK), f32) * GMLP_CHUNK ** -0.5,
        "spatial_b": 1.0 + 0.1 * nrm(ks[7], (DEPTH, GMLP_GROUPS, GMLP_CHUNK), f32),
        "rel_bias": 0.2 * nrm(ks[8], (REL_BUCKETS, MOBA_HEADS), f32),
        "mem_norm_g": 1.0 + 0.02 * nrm(ks[9], (DEPTH, D_MODEL), f32),
        "w_mem_kv": nrm(ks[10], (DEPTH, D_MODEL, 2 * D_MEM), f32) * D_MODEL ** -0.5,
        "branch_norm_g": 1.0 + 0.02 * nrm(ks[11], (DEPTH, D_MIX), f32),
        "w_out": nrm(ks[12], (DEPTH, D_MIX, D_MODEL), f32) * (0.5 * D_MIX ** -0.5),
        "final_norm_g": 1.0 + 0.02 * nrm(ks[13], (D_MODEL,), f32),
    }


def reference(x, mem, norm_g, w_in, gmlp_ln_g, gmlp_ln_b, spatial_w, spatial_b, rel_bias,
              mem_norm_g, w_mem_kv, branch_norm_g, w_out, final_norm_g):
    split_at = list(np.cumsum([D_GMLP, D_GMLP, D_MOBA, D_MOBA, D_MOBA, D_MEM]))
    for l in range(DEPTH):
        h = rmsnorm(x, norm_g[l])
        proj = h @ w_in[l]
        u_a, v_a, q_b, k_b, v_b, q_m, z = jnp.split(proj, split_at, axis=-1)
        y_a = gmlp_branch(u_a, v_a, gmlp_ln_g[l], gmlp_ln_b[l], spatial_w[l], spatial_b[l])
        y_b = moba_branch(q_b, k_b, v_b, rel_bias)
        y_m = memory_branch(q_m, rmsnorm(mem, mem_norm_g[l]), w_mem_kv[l])
        g = branch_norm_g[l]
        y = jnp.concatenate([
            rmsnorm(y_a, g[:D_GMLP]),
            rmsnorm(y_b, g[D_GMLP:D_GMLP + D_MOBA]),
            rmsnorm(y_m, g[D_GMLP + D_MOBA:]),
        ], axis=-1) * jax.nn.silu(z)
        x = x + y @ w_out[l]
    return rmsnorm(x, final_norm_g)
```

```cpp
#include <hip/hip_runtime.h>
#include <cstdio>
#include <cstdint>

#define LAS __attribute__((address_space(3)))
#define GAS __attribute__((address_space(1)))
typedef _Float16 half_t;
typedef _Float16 h8 __attribute__((ext_vector_type(8)));
typedef _Float16 h4 __attribute__((ext_vector_type(4)));
typedef _Float16 h2 __attribute__((ext_vector_type(2)));
typedef float f32x2 __attribute__((ext_vector_type(2)));
typedef float f32x4 __attribute__((ext_vector_type(4)));
typedef float f32x16 __attribute__((ext_vector_type(16)));
typedef unsigned u32x2 __attribute__((ext_vector_type(2)));
typedef unsigned u32x4 __attribute__((ext_vector_type(4)));

constexpr int NB = 16, SEQ = 2048, DM = 1024, MTOK = NB * SEQ, MEML = 256, MMEM = NB * MEML;
constexpr int DIN = 3200, NP1 = 3328, NKV = 512, NB1 = NP1 + NKV;
constexpr int C_U = 0, C_V = 384, C_QB = 768, C_KB = 1152, C_VB = 1536, C_QM = 1920, C_Z = 2176;
constexpr int PP = DIN;
constexpr float EPS = 1e-6f;
constexpr int NWAVES = 8, NTHR = 512;

constexpr size_t MiB = 1u << 20;
constexpr size_t WS_CTL = 0, CTL_ZERO_BYTES = 256 * 1024;
constexpr size_t WS_SSX = 1 * MiB;
constexpr size_t WS_SSY = 2 * MiB;
constexpr size_t WS_KMEAN = 4 * MiB;
constexpr size_t WS_LUT = 4 * MiB + 512 * 1024;
constexpr size_t WS_WSP = 5 * MiB;
constexpr size_t WS_BT2 = 6 * MiB;
constexpr size_t WS_BT1 = 10 * MiB;
constexpr size_t WS_MKV = 26 * MiB;
constexpr size_t WS_XH = 34 * MiB;
constexpr size_t WS_Y = 106 * MiB;
constexpr size_t WS_PROJ = 170 * MiB;
constexpr size_t WS_END = 370 * MiB;
constexpr int CW_TMO = 0, CW_BAR = 4096, CW_QUEUE = 8192;

constexpr int RING_BYTES = 131072;
constexpr int AT_STG_ROW = 68;
constexpr int GM_VNT = 0, GM_VNT_ROW = 136, GM_VNT_BYTES = 64 * GM_VNT_ROW * 2;
constexpr int GM_STAGE = 36864;
constexpr int MISC_OFF = 155648;
constexpr int LDS_BYTES = MISC_OFF + 256;
static_assert(RING_BYTES + 2 * 768 * 4 <= MISC_OFF, "LDS map");

__device__ __forceinline__ unsigned pkh(float lo, float hi) { f32x2 v = {lo, hi}; h2 h = __builtin_convertvector(v, h2); return __builtin_bit_cast(unsigned, h); }
__device__ __forceinline__ float gelu_t(float x) { const float t = x * (1.0f + 0.044715f * x * x) * (2.0f * 0.7978845608028654f * 1.4426950408889634f); return x * __builtin_amdgcn_rcpf(1.0f + __builtin_amdgcn_exp2f(-t)); }
__device__ __forceinline__ float silu_f(float x) { return x * __builtin_amdgcn_rcpf(1.0f + __builtin_amdgcn_exp2f(-x * 1.4426950408889634f)); }
__device__ __forceinline__ f32x2 silu_pk(f32x2 v) { const f32x2 w = v * (-1.4426950408889634f); f32x2 e; e.x = __builtin_amdgcn_exp2f(w.x); e.y = __builtin_amdgcn_exp2f(w.y);
    const f32x2 d = e + 1.0f; f32x2 r; r.x = __builtin_amdgcn_rcpf(d.x); r.y = __builtin_amdgcn_rcpf(d.y); return v * r; }
__device__ __forceinline__ f32x2 gelu_pk(f32x2 v) { constexpr float k1 = 2.0f * 0.7978845608028654f * 1.4426950408889634f, k2 = 0.044715f;
    const f32x2 t = v * v, u = t * (-k1 * k2) + (-k1), w = v * u; f32x2 e; e.x = __builtin_amdgcn_exp2f(w.x); e.y = __builtin_amdgcn_exp2f(w.y);
    const f32x2 d = e + 1.0f; f32x2 r; r.x = __builtin_amdgcn_rcpf(d.x); r.y = __builtin_amdgcn_rcpf(d.y); return v * r; }
__device__ __forceinline__ float wave_sum(float v) {
#pragma unroll
    for (int o = 1; o < 64; o <<= 1) v += __shfl_xor(v, o);
    return v;
}
__device__ __forceinline__ int t5_bucket(int d) {
    if (d < 16) return d;
    return 16 + (d >= 19) + (d >= 21) + (d >= 24) + (d >= 27) + (d >= 31) + (d >= 35) + (d >= 40) + (d >= 46) + (d >= 52) + (d >= 59) + (d >= 67) + (d >= 77) + (d >= 87) + (d >= 99) + (d >= 113);
}

namespace pg8 {
constexpr int BM = 256, BK = 64, HALF = 128, HTB = HALF * BK * 2, STAGE_BYTES = 8 * HTB;
__host__ __device__ __forceinline__ int lds_byte(int r, int c) { const int st = (r >> 4) * 2 + (c >> 5), rr = r & 15, cc = c & 31, ob = rr * 64 + cc * 2; return st * 1024 + (ob ^ (((ob >> 9) & 1) << 5)); }
__host__ __device__ __forceinline__ void stage_rc(int b, int& R, int& C) { const int st = b / 1024, sb = b % 1024, swz = sb ^ (((sb >> 9) & 1) << 5); R = (st >> 1) * 16 + swz / 64; C = (st & 1) * 32 + (swz % 64) / 2; }
__host__ __device__ __forceinline__ int perm32(int rho) { const int n = rho >> 4, i = rho & 15; return 8 * (i >> 2) + 4 * n + (i & 3); }
struct Unit { int pm, pn; };
struct Gemm { const half_t* A; const half_t* Bt; int K; const float* ssy; };

template <class Epi, class Sched, bool KSCALE>
__device__ __forceinline__ void gemm_phase(LAS unsigned char* lds, const Gemm g, const Sched& S, const Epi& E) {
    int tid_ = threadIdx.x; asm volatile("" : "+v"(tid_));
    const int tid = tid_, wid = __builtin_amdgcn_readfirstlane(tid >> 6), lane = tid & 63, wr = wid >> 2, wc = wid & 3, fr = lane & 15, fq = lane >> 4;
    const int K = g.K, nt = K / BK;
    unsigned voffA[2], voffB[2];
#pragma unroll
    for (int i = 0; i < 2; ++i) { int R, C; stage_rc(tid * 16 + i * 8192, R, C); const int Rb = (R & ~31) + perm32(R & 31);
        voffA[i] = (unsigned)(R * K + C) * 2u; voffB[i] = (unsigned)(Rb * K + C) * 2u; }
    const size_t kstep = (size_t)(BK * 2);
    const size_t hstep = (size_t)HALF * K * 2;
    const size_t tstep = 2 * hstep;
    const unsigned ldsw = (unsigned)wid * 1024u;
    const int aoff = lds_byte(wr * 64 + fr, fq * 8), boff = lds_byte(wc * 32 + fr, fq * 8);
#define PG8_SA(b, h) (((b) * 2 + (h)) * HTB)
#define PG8_SB(b, h) ((4 + (b) * 2 + (h)) * HTB)
#define PG8_STAGE(bufoff, gbase, voff) do { _Pragma("unroll") for (int _i = 0; _i < 2; ++_i) \
        __builtin_amdgcn_global_load_lds((const unsigned*)((const char*)(gbase) + (voff)[_i]), (LAS unsigned*)(lds + (bufoff) + ldsw + _i * 8192), 16, 0, 0); } while (0)
#define PG8_LDA(dst, b, h) do { _Pragma("unroll") for (int m = 0; m < 4; ++m) _Pragma("unroll") for (int k = 0; k < 2; ++k) dst[m][k] = *(const LAS h8*)(lds + PG8_SA(b, h) + aoff + m * 2048 + k * 1024); } while (0)
#define PG8_LDB(dst, b, h) do { _Pragma("unroll") for (int n = 0; n < 2; ++n) _Pragma("unroll") for (int k = 0; k < 2; ++k) dst[n][k] = *(const LAS h8*)(lds + PG8_SB(b, h) + boff + n * 2048 + k * 1024); } while (0)
#define PG8_MMA(ai, bj, At, Bt) do { __builtin_amdgcn_s_setprio(1); _Pragma("unroll") for (int m = 0; m < 4; ++m) _Pragma("unroll") for (int n = 0; n < 2; ++n) _Pragma("unroll") for (int k = 0; k < 2; ++k) \
        acc[ai][bj][m][n] = __builtin_amdgcn_mfma_f32_16x16x32_f16(Bt[n][k], At[m][k], acc[ai][bj][m][n], 0, 0, 0); __builtin_amdgcn_s_setprio(0); } while (0)
#define PG8_WAIT_V(n) asm volatile("s_waitcnt vmcnt(" #n ")" ::: "memory")
#define PG8_WAIT_L(n) asm volatile("s_waitcnt lgkmcnt(" #n ")" ::: "memory")
#define PG8_BAR __builtin_amdgcn_s_barrier()
#define PG8_SCHED __builtin_amdgcn_sched_barrier(0)
    Unit cur, nxt; int ui = 0;
    if (!S.next(0, cur)) return;
    f32x4 acc[2][2][4][2];
#pragma unroll
    for (int a = 0; a < 2; ++a)
#pragma unroll
        for (int b = 0; b < 2; ++b)
#pragma unroll
            for (int m = 0; m < 4; ++m)
#pragma unroll
                for (int n = 0; n < 2; ++n) acc[a][b][m][n] = (f32x4){0.f, 0.f, 0.f, 0.f};
    h8 At[4][2], B0[2][2], B1[2][2];
    const char* cA = (const char*)g.A + (size_t)cur.pm * tstep; const char* cB = (const char*)g.Bt + (size_t)cur.pn * tstep;
    PG8_STAGE(PG8_SB(0, 0), cB, voffB); PG8_STAGE(PG8_SB(0, 1), cB + hstep, voffB); PG8_STAGE(PG8_SA(0, 0), cA, voffA); PG8_STAGE(PG8_SA(0, 1), cA + hstep, voffA);
    if (wr == 1) PG8_BAR;
    PG8_WAIT_V(2); PG8_BAR;
    PG8_STAGE(PG8_SB(1, 0), cB + kstep, voffB); PG8_STAGE(PG8_SA(1, 0), cA + kstep, voffA); PG8_STAGE(PG8_SB(1, 1), cB + hstep + kstep, voffB);
    PG8_WAIT_V(6); PG8_BAR;
    LAS float* ktab = (LAS float*)(lds + RING_BYTES);
    for (;;) {
        const bool has_next = S.next(ui + 1, nxt);
        if constexpr (KSCALE) {
            if (tid < 256) { const f32x4* sp = (const f32x4*)(g.ssy + (size_t)(cur.pm * BM + tid) * 16); const f32x4 s0 = sp[0], s1 = sp[1], s2 = sp[2], s3 = sp[3];
                const float sa = ((s0[0] + s0[1]) + (s0[2] + s0[3])) + (s1[0] + s1[1]), sb = ((s1[2] + s1[3]) + (s2[0] + s2[1])) + (s2[2] + s2[3]), sm = (s3[0] + s3[1]) + (s3[2] + s3[3]);
                const float va = sa * (1.0f / 384.0f) + EPS, vb = sb * (1.0f / 384.0f) + EPS, vm = sm * (1.0f / 256.0f) + EPS;
                LAS float* T = ktab + (ui & 1) * 768;
                T[tid] = sqrtf(vb / va); T[256 + tid] = sqrtf(vm / vb); T[512 + tid] = __builtin_amdgcn_rsqf(vm); }
        }
        const char* nA = has_next ? (const char*)g.A + (size_t)nxt.pm * tstep : cA; const char* nB = has_next ? (const char*)g.Bt + (size_t)nxt.pn * tstep : cB;
        for (int t = 0; t < nt; t += 2) {
            const bool last = (t == nt - 2);
            const char* a1 = cA + (size_t)(t + 1) * kstep;
            const char* a2 = last ? nA : cA + (size_t)(t + 2) * kstep; const char* b2 = last ? nB : cB + (size_t)(t + 2) * kstep;
            const char* a3 = a2 + kstep; const char* b3 = b2 + kstep;
            if constexpr (KSCALE) {
                if (t == 6 || t == 12) { const LAS float* T = ktab + (ui & 1) * 768 + (t == 12 ? 256 : 0);
#pragma unroll
                    for (int ai = 0; ai < 2; ++ai)
#pragma unroll
                        for (int m = 0; m < 4; ++m) { const float f = T[ai * HALF + wr * 64 + m * 16 + fr];
#pragma unroll
                            for (int bj = 0; bj < 2; ++bj)
#pragma unroll
                                for (int n = 0; n < 2; ++n) acc[ai][bj][m][n] *= f; } }
            }
            PG8_LDB(B0, 0, 0); PG8_LDB(B1, 0, 1); PG8_SCHED; PG8_LDA(At, 0, 0); PG8_STAGE(PG8_SA(1, 1), a1 + hstep, voffA);
            PG8_WAIT_V(8); PG8_WAIT_L(0); PG8_BAR; PG8_MMA(0, 0, At, B0); PG8_MMA(0, 1, At, B1); PG8_BAR; PG8_SCHED;
            PG8_LDA(At, 0, 1); PG8_STAGE(PG8_SB(0, 0), b2, voffB); PG8_STAGE(PG8_SB(0, 1), b2 + hstep, voffB); PG8_STAGE(PG8_SA(0, 0), a2, voffA);
            PG8_WAIT_V(8); PG8_WAIT_L(0); PG8_BAR; PG8_MMA(1, 0, At, B0); PG8_MMA(1, 1, At, B1); PG8_BAR; PG8_SCHED;
            PG8_LDB(B0, 1, 0); PG8_LDB(B1, 1, 1); PG8_SCHED; PG8_LDA(At, 1, 0); PG8_STAGE(PG8_SA(0, 1), a2 + hstep, voffA);
            PG8_WAIT_V(8); PG8_WAIT_L(0); PG8_BAR; PG8_MMA(0, 0, At, B0); PG8_MMA(0, 1, At, B1); PG8_BAR; PG8_SCHED;
            PG8_LDA(At, 1, 1); PG8_STAGE(PG8_SB(1, 0), b3, voffB); PG8_STAGE(PG8_SB(1, 1), b3 + hstep, voffB); PG8_STAGE(PG8_SA(1, 0), a3, voffA);
            PG8_WAIT_V(8); PG8_WAIT_L(0); PG8_BAR; PG8_MMA(1, 0, At, B0); PG8_MMA(1, 1, At, B1); PG8_BAR; PG8_SCHED;
        }
        if (wr == 0) PG8_BAR;
        E(acc, cur, wr, wc, fr, fq, ktab + (ui & 1) * 768 + 512);
        if (!has_next) break;
#pragma unroll
        for (int a = 0; a < 2; ++a)
#pragma unroll
            for (int b = 0; b < 2; ++b)
#pragma unroll
                for (int m = 0; m < 4; ++m)
#pragma unroll
                    for (int n = 0; n < 2; ++n) acc[a][b][m][n] = (f32x4){0.f, 0.f, 0.f, 0.f};
        cur = nxt; cA = nA; cB = nB; ++ui;
        if (wr == 1) PG8_BAR;
    }
    PG8_WAIT_V(0);
    PG8_BAR;
#undef PG8_SA
#undef PG8_SB
#undef PG8_STAGE
#undef PG8_LDA
#undef PG8_LDB
#undef PG8_MMA
#undef PG8_WAIT_V
#undef PG8_WAIT_L
#undef PG8_BAR
#undef PG8_SCHED
}

struct Order1 {
    int G, c;
    __device__ __forceinline__ bool next(int i, Unit& u) const {
        const int L = i * G + c, x = L % 8, off = L / 8;
        if (off < 208) { const int w = x * 208 + off; const int nig = 8 * 13, gid = w / nig, rem = w % nig; u.pm = gid * 8 + (rem % 8); u.pn = rem / 8; return true; }
        if (off < 212) { const int k = off - 208; u.pm = 128 + 2 * x + (k >> 1); u.pn = 13 + (k & 1); return true; }
        return false;
    }
};
struct Order2 {
    int G, c;
    __device__ __forceinline__ bool next(int i, Unit& u) const {
        const int L = i * G + c; constexpr int NW = 128 * 4;
        if (L >= NW) return false;
        const int q = NW / 8, xcd = L % 8, off = L / 8, w = xcd * q + off; const int nig = 8 * 4, gid = w / nig, rem = w % nig; u.pm = gid * 8 + (rem % 8); u.pn = rem / 8; return true;
    }
};

struct EpiProj {
    half_t* proj; half_t* mkv; const float* ssx; float* kmsum;
    __device__ __forceinline__ void operator()(const f32x4 (&acc)[2][2][4][2], const Unit& u, int wr, int wc, int fr, int fq, const LAS float*) const {
        if (u.pm >= 128) {
            const int row0 = (u.pm - 128) * BM + wr * 64 + fr, col0 = (u.pn - 13) * BM + wc * 32 + 8 * fq;
#pragma unroll
            for (int ai = 0; ai < 2; ++ai)
#pragma unroll
                for (int m = 0; m < 4; ++m) { half_t* rowp = mkv + (size_t)(row0 + ai * HALF + m * 16) * NKV + col0;
#pragma unroll
                    for (int bj = 0; bj < 2; ++bj) { const f32x4 v0 = acc[ai][bj][m][0], v1 = acc[ai][bj][m][1]; u32x4 w; w.x = pkh(v0[0], v0[1]); w.y = pkh(v0[2], v0[3]); w.z = pkh(v1[0], v1[1]); w.w = pkh(v1[2], v1[3]);
                        *(u32x4*)(rowp + bj * HALF) = w; } }
            return;
        }
        const int row0 = u.pm * BM + wr * 64 + fr;
        float rs[2][4];
#pragma unroll
        for (int ai = 0; ai < 2; ++ai)
#pragma unroll
            for (int m = 0; m < 4; ++m) rs[ai][m] = ssx[row0 + ai * HALF + m * 16];
#pragma unroll
        for (int ai = 0; ai < 2; ++ai)
#pragma unroll
            for (int m = 0; m < 4; ++m) rs[ai][m] = __builtin_amdgcn_rsqf(rs[ai][m] * (1.0f / DM) + EPS);
#pragma unroll
        for (int bj = 0; bj < 2; ++bj) {
            const int c128 = u.pn * 2 + bj;
            if (c128 >= 25) continue;
            const int col0 = c128 * HALF + wc * 32 + 8 * fq;
            if (c128 >= 9 && c128 < 12) {
                f32x4 c0 = (f32x4){0.f, 0.f, 0.f, 0.f}, c1 = c0;
#pragma unroll
                for (int ai = 0; ai < 2; ++ai)
#pragma unroll
                    for (int m = 0; m < 4; ++m) { c0 += acc[ai][bj][m][0] * rs[ai][m]; c1 += acc[ai][bj][m][1] * rs[ai][m]; }
#pragma unroll
                for (int e = 0; e < 4; ++e) {
#pragma unroll
                    for (int o = 1; o < 16; o <<= 1) { c0[e] += __shfl_xor(c0[e], o); c1[e] += __shfl_xor(c1[e], o); } }
                if (fr == 0) { float* kp = kmsum + (size_t)u.pm * 384 + (col0 - C_KB);
#pragma unroll
                    for (int e = 0; e < 4; ++e) { atomicAdd(kp + e, c0[e]); atomicAdd(kp + 4 + e, c1[e]); } }
            }
#pragma unroll
            for (int ai = 0; ai < 2; ++ai)
#pragma unroll
                for (int m = 0; m < 4; ++m) { const int row = row0 + ai * HALF + m * 16;
                    f32x4 v0 = acc[ai][bj][m][0] * rs[ai][m], v1 = acc[ai][bj][m][1] * rs[ai][m];
                    if (c128 >= 17) {
#pragma unroll
                        for (int e = 0; e < 4; e += 2) { const f32x2 a = silu_pk((f32x2){v0[e], v0[e + 1]}), b = silu_pk((f32x2){v1[e], v1[e + 1]}); v0[e] = a.x; v0[e + 1] = a.y; v1[e] = b.x; v1[e + 1] = b.y; } }
                    else if (c128 < 6) {
#pragma unroll
                        for (int e = 0; e < 4; e += 2) { const f32x2 a = gelu_pk((f32x2){v0[e], v0[e + 1]}), b = gelu_pk((f32x2){v1[e], v1[e + 1]}); v0[e] = a.x; v0[e + 1] = a.y; v1[e] = b.x; v1[e + 1] = b.y; } }
                    u32x4 w; w.x = pkh(v0[0], v0[1]); w.y = pkh(v0[2], v0[3]); w.z = pkh(v1[0], v1[1]); w.w = pkh(v1[2], v1[3]);
                    *(u32x4*)(proj + (size_t)row * PP + col0) = w; }
        }
    }
};
struct EpiResid {
    const half_t* resid16; half_t* xh; float* ssn;
    __device__ __forceinline__ void operator()(const f32x4 (&acc)[2][2][4][2], const Unit& u, int wr, int wc, int fr, int fq, const LAS float* T3) const {
        const int row0 = u.pm * BM + wr * 64 + fr, col0 = u.pn * BM + wc * 32 + 8 * fq;
#pragma unroll
        for (int ai = 0; ai < 2; ++ai) {
            h8 rh[4][2]; float f3[4];
#pragma unroll
            for (int m = 0; m < 4; ++m) { const size_t off = (size_t)(row0 + ai * HALF + m * 16) * DM + col0;
                rh[m][0] = *(const h8*)(resid16 + off); rh[m][1] = *(const h8*)(resid16 + off + HALF); f3[m] = T3[ai * HALF + wr * 64 + m * 16 + fr]; }
#pragma unroll
            for (int m = 0; m < 4; ++m) { const int row = row0 + ai * HALF + m * 16; const size_t off = (size_t)row * DM + col0; float s = 0.f; f32x2 s2 = {0.f, 0.f};
#pragma unroll
                for (int bj = 0; bj < 2; ++bj) { const h8 r = rh[m][bj];
                    const f32x4 v0 = acc[ai][bj][m][0] * f3[m] + (f32x4){(float)r[0], (float)r[1], (float)r[2], (float)r[3]}, v1 = acc[ai][bj][m][1] * f3[m] + (f32x4){(float)r[4], (float)r[5], (float)r[6], (float)r[7]};
                    u32x4 w; w.x = pkh(v0[0], v0[1]); w.y = pkh(v0[2], v0[3]); w.z = pkh(v1[0], v1[1]); w.w = pkh(v1[2], v1[3]);
                    *(u32x4*)(xh + off + bj * HALF) = w;
                    s2 = (f32x2){v0[0], v0[1]} * (f32x2){v0[0], v0[1]} + s2; s2 = (f32x2){v0[2], v0[3]} * (f32x2){v0[2], v0[3]} + s2;
                    s2 = (f32x2){v1[0], v1[1]} * (f32x2){v1[0], v1[1]} + s2; s2 = (f32x2){v1[2], v1[3]} * (f32x2){v1[2], v1[3]} + s2; }
                s = s2.x + s2.y;
                s += __shfl_xor(s, 16); s += __shfl_xor(s, 32);
                if (fq == 0) atomicAdd(ssn + row, s); }
            asm volatile("" ::: "memory");
        }
    }
};
}

#define XB_TMO      128
#define XB_XCNT(j)  (256  + 64 * (j))
#define XB_XSUB(j)  (1280 + 64 * (j))
#define XB_XGEN(j)  (2304 + 64 * (j))
#define XB_TOP      3328
#define XB_TOPGEN   3392
#define XCD_BAR_WORDS 3456
#define XB_SPIN_CAP (1u << 18)
__device__ __forceinline__ unsigned xb_ld(unsigned* p)              { return __hip_atomic_load(p, __ATOMIC_RELAXED, __HIP_MEMORY_SCOPE_AGENT); }
__device__ __forceinline__ unsigned xb_add(unsigned* p, unsigned v) { return __hip_atomic_fetch_add(p, v, __ATOMIC_RELAXED, __HIP_MEMORY_SCOPE_AGENT); }
__device__ __forceinline__ unsigned xb_xcc_id() { return (unsigned)__builtin_amdgcn_s_getreg((3 << 11) | 20) & 0xFu; }
#define XB_SPIN(cond, bar) do { unsigned _sp = 0; while (cond) { __builtin_amdgcn_s_sleep(1); \
    if ((++_sp & 255u) == 0u) { if (xb_ld(&(bar)[XB_TMO])) break; if (_sp > XB_SPIN_CAP) { atomicAdd(&(bar)[XB_TMO], 1u); break; } } } } while (0)
struct XcdBarrier { unsigned* bar; unsigned x; volatile LAS unsigned* st; };
__device__ __forceinline__ XcdBarrier xcd_barrier_post(unsigned* bar, volatile LAS unsigned* st) {
    XcdBarrier b; b.bar = bar; b.x = xb_xcc_id(); b.st = st;
    if (threadIdx.x == 0) (void)xb_add(&bar[XB_XCNT(b.x)], 1u);
    return b;
}
__device__ __forceinline__ void xcd_barrier_complete(unsigned* bar, unsigned x, unsigned& nloc, unsigned& nx) {
    const unsigned G = gridDim.x * gridDim.y * gridDim.z;
    unsigned sum, cnt, mine, sp = 0u;
    for (;;) {
        sum = 0u; cnt = 0u; mine = 0u;
#pragma unroll
        for (unsigned j = 0; j < 16; ++j) { const unsigned c = xb_ld(&bar[XB_XCNT(j)]); sum += c; cnt += (c > 0u) ? 1u : 0u; mine = (j == x) ? c : mine; }
        if (sum == G) break;
        __builtin_amdgcn_s_sleep(1);
        if ((++sp & 255u) == 0u) { if (xb_ld(&bar[XB_TMO])) break; if (sp > XB_SPIN_CAP) { atomicAdd(&bar[XB_TMO], 1u); break; } }
    }
    nloc = mine > 0u ? mine : 1u; nx = cnt > 0u ? cnt : 1u;
}
__device__ __forceinline__ void xcd_barrier(const XcdBarrier& b) {
    asm volatile("s_waitcnt vmcnt(0)" ::: "memory");
    __syncthreads();
    if (threadIdx.x == 0) {
        unsigned* bar = b.bar;
        __builtin_amdgcn_s_waitcnt(0);
        unsigned nloc = b.st[0], nx = b.st[1];
        if (nloc == 0u) { xcd_barrier_complete(bar, b.x, nloc, nx); b.st[0] = nloc; b.st[1] = nx; }
        const unsigned old = xb_add(&bar[XB_XSUB(b.x)], 1u);
        const unsigned gen = old / nloc;
        if (old + 1u == (gen + 1u) * nloc) {
            __builtin_amdgcn_fence(__ATOMIC_RELEASE, "agent");
            asm volatile("s_waitcnt vmcnt(0)" ::: "memory");
            const unsigned og = xb_add(&bar[XB_TOP], 1u);
            const unsigned tg = og / nx;
            if (og + 1u == (tg + 1u) * nx) xb_add(&bar[XB_TOPGEN], 1u);
            else XB_SPIN(xb_ld(&bar[XB_TOPGEN]) == tg, bar);
            __builtin_amdgcn_fence(__ATOMIC_ACQUIRE, "agent");
            xb_add(&bar[XB_XGEN(b.x)], 1u);
            asm volatile("s_waitcnt vmcnt(0)" ::: "memory");
        } else {
            XB_SPIN(xb_ld(&bar[XB_XGEN(b.x)]) == gen, bar);
            __builtin_amdgcn_fence(__ATOMIC_ACQUIRE, "agent");
            asm volatile("s_waitcnt vmcnt(0)" ::: "memory");
        }
    }
    __syncthreads();
}

constexpr int GB_BASE = 32768;
#define GB_XCNT(g, x) (GB_BASE + ((g) * 16 + (x)) * 64)
#define GB_XSUB(g, x) (GB_BASE + 8192 + ((g) * 16 + (x)) * 64)
#define GB_XGEN(g, x) (GB_BASE + 16384 + ((g) * 16 + (x)) * 64)
#define GB_TOP(g)     (GB_BASE + 24576 + (g) * 64)
#define GB_TOPGEN(g)  (GB_BASE + 25088 + (g) * 64)
constexpr int GB_END = GB_BASE + 25600;
static_assert((size_t)GB_END * 4 <= CTL_ZERO_BYTES, "control words inside the zeroed region");
struct GrpBarrier { unsigned* ctl; unsigned g, x, gsize; volatile LAS unsigned* st; };
__device__ __forceinline__ GrpBarrier grp_barrier_post(unsigned* ctl, volatile LAS unsigned* st) {
    GrpBarrier b; b.ctl = ctl; b.g = blockIdx.x & 7u; b.x = xb_xcc_id(); b.gsize = (gridDim.x + 7u - b.g) / 8u; b.st = st;
    if (threadIdx.x == 0) (void)xb_add(&ctl[GB_XCNT(b.g, b.x)], 1u);
    return b;
}
__device__ __forceinline__ void grp_barrier_complete(const GrpBarrier& b, unsigned& nloc, unsigned& nx) {
    unsigned* tmo = b.ctl + CW_BAR;
    unsigned sum, cnt, mine, sp = 0u;
    for (;;) {
        sum = 0u; cnt = 0u; mine = 0u;
#pragma unroll
        for (unsigned j = 0; j < 16; ++j) { const unsigned c = xb_ld(&b.ctl[GB_XCNT(b.g, j)]); sum += c; cnt += (c > 0u) ? 1u : 0u; mine = (j == b.x) ? c : mine; }
        if (sum == b.gsize) break;
        __builtin_amdgcn_s_sleep(1);
        if ((++sp & 255u) == 0u) { if (xb_ld(&tmo[XB_TMO])) break; if (sp > XB_SPIN_CAP) { atomicAdd(&tmo[XB_TMO], 1u); break; } }
    }
    nloc = mine > 0u ? mine : 1u; nx = cnt > 0u ? cnt : 1u;
}
__device__ __forceinline__ void grp_barrier(const GrpBarrier& b) {
    asm volatile("s_waitcnt vmcnt(0)" ::: "memory");
    __syncthreads();
    if (threadIdx.x == 0) {
        unsigned* ctl = b.ctl; unsigned* tmo = ctl + CW_BAR;
        __builtin_amdgcn_s_waitcnt(0);
        unsigned nloc = b.st[0], nx = b.st[1];
        if (nloc == 0u) { grp_barrier_complete(b, nloc, nx); b.st[0] = nloc; b.st[1] = nx; }
        const unsigned old = xb_add(&ctl[GB_XSUB(b.g, b.x)], 1u);
        const unsigned gen = old / nloc;
        if (old + 1u == (gen + 1u) * nloc) {
            __builtin_amdgcn_fence(__ATOMIC_RELEASE, "agent");
            asm volatile("s_waitcnt vmcnt(0)" ::: "memory");
            const unsigned og = xb_add(&ctl[GB_TOP(b.g)], 1u);
            const unsigned tg = og / nx;
            if (og + 1u == (tg + 1u) * nx) xb_add(&ctl[GB_TOPGEN(b.g)], 1u);
            else XB_SPIN(xb_ld(&ctl[GB_TOPGEN(b.g)]) == tg, tmo);
            __builtin_amdgcn_fence(__ATOMIC_ACQUIRE, "agent");
            xb_add(&ctl[GB_XGEN(b.g, b.x)], 1u);
            asm volatile("s_waitcnt vmcnt(0)" ::: "memory");
        } else {
            XB_SPIN(xb_ld(&ctl[GB_XGEN(b.g, b.x)]) == gen, tmo);
            __builtin_amdgcn_fence(__ATOMIC_ACQUIRE, "agent");
            asm volatile("s_waitcnt vmcnt(0)" ::: "memory");
        }
    }
    __syncthreads();
}

struct Args {
    const float* x; const float* mem; const float* norm_g; const float* w_in; const float* ln_g; const float* ln_b; const float* sp_w; const float* sp_b;
    const float* rel_bias; const float* mem_norm_g; const float* w_kv; const float* br_g; const float* w_out; const float* fin_g;
    float* out; unsigned char* ws; int ph_lo, ph_hi;
};
struct Frame {
    LAS unsigned char* lds; int tid, lane, wave, G, bid;
    unsigned* ctl; float* ssx; float* ssy; float* kmean; half_t* wsp; half_t* bt2; half_t* bt1; half_t* mkv; half_t* xh; half_t* y; half_t* proj;
};
typedef const Args __attribute__((address_space(4))) * KArgs;
__device__ __forceinline__ KArgs kargs() { unsigned long long v = (unsigned long long)__builtin_amdgcn_kernarg_segment_ptr(); asm volatile("" : "+s"(v)); return (KArgs)v; }
__device__ __forceinline__ Args load_args() {
    KArgs p = kargs(); Args a;
    a.x = p->x; a.mem = p->mem; a.norm_g = p->norm_g; a.w_in = p->w_in; a.ln_g = p->ln_g; a.ln_b = p->ln_b; a.sp_w = p->sp_w; a.sp_b = p->sp_b;
    a.rel_bias = p->rel_bias; a.mem_norm_g = p->mem_norm_g; a.w_kv = p->w_kv; a.br_g = p->br_g; a.w_out = p->w_out; a.fin_g = p->fin_g;
    a.out = p->out; a.ws = p->ws; a.ph_lo = p->ph_lo; a.ph_hi = p->ph_hi;
    return a;
}
__device__ __forceinline__ Frame make_frame(LAS unsigned char* lds, const Args& a) {
    Frame F; F.lds = lds;
    int t = threadIdx.x; asm volatile("" : "+v"(t));
    F.tid = t; F.lane = t & 63; F.wave = __builtin_amdgcn_readfirstlane(t >> 6); F.G = gridDim.x; F.bid = blockIdx.x;
    unsigned char* ws = a.ws;
    F.ctl = (unsigned*)(ws + WS_CTL); F.ssx = (float*)(ws + WS_SSX); F.ssy = (float*)(ws + WS_SSY); F.kmean = (float*)(ws + WS_KMEAN);
    F.wsp = (half_t*)(ws + WS_WSP); F.bt2 = (half_t*)(ws + WS_BT2); F.bt1 = (half_t*)(ws + WS_BT1); F.mkv = (half_t*)(ws + WS_MKV);
    F.xh = (half_t*)(ws + WS_XH); F.y = (half_t*)(ws + WS_Y); F.proj = (half_t*)(ws + WS_PROJ);
    return F;
}

__device__ __forceinline__ void p0_transpose_item(const float* W, int K, int N, half_t* WT, int row_off, const float* gk, bool qscale, LAS float* scr, int item, int lane) {
    const int nblk = N / 32, kb = item / nblk, nb = item % nblk, k0 = 64 * kb, n0 = 32 * nb;
#pragma unroll 8
    for (int i = 0; i < 32; ++i) { const int kk = 2 * i + (lane >> 5); scr[kk * 33 + (lane & 31)] = __builtin_nontemporal_load(W + (size_t)(k0 + kk) * N + n0 + (lane & 31)) * gk[k0 + kk]; }
    asm volatile("s_waitcnt lgkmcnt(0)" ::: "memory");
    const int c = lane & 7;
#pragma unroll
    for (int j = 0; j < 4; ++j) { const int n = (lane >> 3) + 8 * j; const LAS float* s = scr + (8 * c) * 33 + n;
        const int ng = n0 + n; const float sc = (qscale && ((ng >= C_QB && ng < C_KB) || (ng >= C_QM && ng < C_Z))) ? 0.125f * 1.4426950408889634f : 1.0f;
        u32x4 o; o.x = pkh(s[0 * 33] * sc, s[1 * 33] * sc); o.y = pkh(s[2 * 33] * sc, s[3 * 33] * sc); o.z = pkh(s[4 * 33] * sc, s[5 * 33] * sc); o.w = pkh(s[6 * 33] * sc, s[7 * 33] * sc);
        *(u32x4*)(WT + (size_t)(row_off + n0 + n) * K + k0 + 8 * c) = o; }
    asm volatile("s_waitcnt lgkmcnt(0)" ::: "memory");
}
__device__ __forceinline__ float row_to_half(const float* xrow, half_t* orow, bool normalise, int lane) {
    const f32x4* xr = (const f32x4*)xrow + lane;
    f32x4 v[4]; float s = 0.f;
#pragma unroll
    for (int j = 0; j < 4; ++j) { v[j] = xr[64 * j]; s += (v[j].x * v[j].x + v[j].y * v[j].y) + (v[j].z * v[j].z + v[j].w * v[j].w); }
    s = wave_sum(s);
    const float sc = normalise ? __builtin_amdgcn_rsqf(s * (1.0f / DM) + EPS) : 1.0f;
    u32x2* o8 = (u32x2*)orow + lane;
#pragma unroll
    for (int j = 0; j < 4; ++j) { u32x2 w; w.x = pkh(v[j].x * sc, v[j].y * sc); w.y = pkh(v[j].z * sc, v[j].w * sc); o8[64 * j] = w; }
    return s;
}
__device__ __forceinline__ void p0_weights(Frame& F, const Args& a) {
    LAS float* scr = (LAS float*)(F.lds + F.wave * 16384);
    const int gw = F.bid * NWAVES + F.wave, NGW = F.G * NWAVES;
    constexpr int I_IN = (DM / 64) * (DIN / 32), I_KV = (DM / 64) * (NKV / 32), I_OUT = (DM / 64) * (DM / 32);
    constexpr int PER_L = I_IN + I_KV + I_OUT;
    for (int it = gw; it < 2 * PER_L; it += NGW) {
        const int l = it / PER_L; int r = it % PER_L;
        if (r < I_IN) { p0_transpose_item(a.w_in + (size_t)l * DM * DIN, DM, DIN, F.bt1 + (size_t)l * NB1 * DM, 0, a.norm_g + l * DM, true, scr, r, F.lane); continue; } r -= I_IN;
        if (r < I_KV) { p0_transpose_item(a.w_kv + (size_t)l * DM * NKV, DM, NKV, F.bt1 + (size_t)l * NB1 * DM, NP1, a.mem_norm_g + l * DM, false, scr, r, F.lane); continue; } r -= I_KV;
        p0_transpose_item(a.w_out + (size_t)l * DM * DM, DM, DM, F.bt2 + (size_t)l * DM * DM, 0, a.br_g + l * DM, false, scr, r, F.lane);
    }
}
__device__ __forceinline__ void p0_rows(Frame& F, const Args& a) {
    const int gw = F.bid * NWAVES + F.wave, NGW = F.G * NWAVES;
    for (int m0 = gw * 4; m0 < MTOK + MMEM; m0 += NGW * 4) {
        const bool isx = m0 < MTOK; const float* src = isx ? a.x + (size_t)m0 * DM : a.mem + (size_t)(m0 - MTOK) * DM;
        f32x4 v[4][4];
#pragma unroll
        for (int i = 0; i < 4; ++i) { const f32x4* xr = (const f32x4*)(src + (size_t)i * DM) + 2 * F.lane;
#pragma unroll
            for (int j = 0; j < 2; ++j) { v[i][2 * j] = __builtin_nontemporal_load(xr + 128 * j); v[i][2 * j + 1] = __builtin_nontemporal_load(xr + 128 * j + 1); } }
#pragma unroll
        for (int i = 0; i < 4; ++i) { float s = 0.f;
#pragma unroll
            for (int j = 0; j < 4; ++j) s += (v[i][j].x * v[i][j].x + v[i][j].y * v[i][j].y) + (v[i][j].z * v[i][j].z + v[i][j].w * v[i][j].w);
            s = wave_sum(s);
            const float sc = isx ? 1.0f : __builtin_amdgcn_rsqf(s * (1.0f / DM) + EPS);
            u32x4* o16 = (u32x4*)(F.xh + (size_t)(m0 + i) * DM) + F.lane;
#pragma unroll
            for (int j = 0; j < 2; ++j) { u32x4 w; w.x = pkh(v[i][2 * j].x * sc, v[i][2 * j].y * sc); w.y = pkh(v[i][2 * j].z * sc, v[i][2 * j].w * sc);
                w.z = pkh(v[i][2 * j + 1].x * sc, v[i][2 * j + 1].y * sc); w.w = pkh(v[i][2 * j + 1].z * sc, v[i][2 * j + 1].w * sc); o16[64 * j] = w; }
            if (isx && F.lane == 0) F.ssx[m0 + i] = s; }
    }
}
__device__ __forceinline__ void p0_prologue(Frame& F, const Args& a) {
    if (F.wave & 1) { p0_rows(F, a); p0_weights(F, a); } else { p0_weights(F, a); p0_rows(F, a); }
    const int gt = F.bid * NTHR + F.tid, NGT = F.G * NTHR;
    for (int i = gt; i < 2 * 128 * DM / 8; i += NGT) { const int l = i / (128 * DM / 8), r = i % (128 * DM / 8); *(u32x4*)(F.bt1 + (size_t)l * NB1 * DM + (size_t)DIN * DM + (size_t)r * 8) = (u32x4){0u, 0u, 0u, 0u}; }
    for (int i = gt; i < 2 * 6 * 128 * 128; i += NGT) { const int s = i & 127, t = (i >> 7) & 127; F.wsp[i] = (half_t)(s <= t ? a.sp_w[i] : 0.0f); }
    for (int i = gt; i < 2 * MTOK; i += NGT) F.ssx[MTOK + i] = 0.f;
    for (int i = gt; i < 2 * 128 * 384; i += NGT) F.kmean[i] = 0.f;
    for (int i = gt; i < 6 * 768; i += NGT) { const int h = i / 768, d = 511 - (i % 768); ((float*)(a.ws + WS_LUT))[i] = d < 0 ? -INFINITY : a.rel_bias[t5_bucket(d > 127 ? 127 : d) * 6 + h] * 1.4426950408889634f; }
}

namespace fa {
typedef short s16x4 __attribute__((ext_vector_type(4)));
typedef short s16x8 __attribute__((ext_vector_type(8)));
typedef short v4i16_t __attribute__((ext_vector_type(4)));
typedef LAS const unsigned char* lds_cptr;
constexpr int NSLOT = 4, NSLOTV = 4, SLOTB = 8192, KVBLK = 64;
constexpr int LDS_K = 0, LDS_V = NSLOT * SLOTB, LDS_WS = (NSLOT + NSLOTV) * SLOTB, LDS_STG = LDS_WS + 2048, STG_ROW = 68, STG_W = 32 * STG_ROW * 4, LDS_LUT = LDS_STG + 8 * STG_W, LUT_N = 768, LDS_END = LDS_LUT + 6 * LUT_N * 4;
#define SBAR() __builtin_amdgcn_sched_barrier(0)
__device__ __forceinline__ int crow(int r, int hi) { return (r & 3) + 8 * (r >> 2) + 4 * hi; }
__device__ __forceinline__ void glds16(const void* gsrc, unsigned lds_dst) { unsigned keep;
    asm volatile("s_mov_b32 %0, m0\n\ts_mov_b32 m0, %2\n\ts_nop 0\n\tglobal_load_lds_dwordx4 %1, off\n\ts_mov_b32 m0, %0" : "=&s"(keep) : "v"(gsrc), "s"(lds_dst) : "memory"); }
__device__ __forceinline__ float max3f(float a, float b, float c) { float r; asm("v_max3_f32 %0, %1, %2, %3" : "=v"(r) : "v"(a), "v"(b), "v"(c)); return r; }
__device__ __forceinline__ float max2f(float a, float b) { float r; asm("v_max_f32_e32 %0, %1, %2" : "=v"(r) : "v"(a), "v"(b)); return r; }
__device__ __forceinline__ float fadd_s(float a, float b) { float r; asm("v_add_f32_e32 %0, %1, %2" : "=v"(r) : "v"(a), "v"(b)); return r; }
__device__ __forceinline__ float fsub_s(float a, float b) { float r; asm("v_sub_f32_e32 %0, %1, %2" : "=v"(r) : "v"(a), "v"(b)); return r; }
#define WAIT_BAR(N) asm volatile("s_waitcnt vmcnt(" #N ") lgkmcnt(0)\n\ts_barrier" ::: "memory")
__device__ __forceinline__ void qkt(f32x16& p0, f32x16& p1, lds_cptr Kslot, const h8* qr, const f32x16& negm, int r32, int hi) {
    lds_cptr kb = Kslot + hi * 1024 + r32 * 16;
#pragma unroll
    for (int d0 = 0; d0 < 4; ++d0) {
        const h8 b0 = *(const LAS h8*)(kb + d0 * 2048);
        const h8 b1 = *(const LAS h8*)(kb + d0 * 2048 + 512);
        if (d0 == 0) { p0 = __builtin_amdgcn_mfma_f32_32x32x16_f16(b0, qr[0], negm, 0, 0, 0); p1 = __builtin_amdgcn_mfma_f32_32x32x16_f16(b1, qr[0], negm, 0, 0, 0); }
        else { p0 = __builtin_amdgcn_mfma_f32_32x32x16_f16(b0, qr[d0], p0, 0, 0, 0); p1 = __builtin_amdgcn_mfma_f32_32x32x16_f16(b1, qr[d0], p1, 0, 0, 0); } }
}
__device__ __forceinline__ void kload8(h8* kf, lds_cptr kp) {
    kf[0] = *(const LAS h8*)(kp);        kf[1] = *(const LAS h8*)(kp + 512);
    kf[2] = *(const LAS h8*)(kp + 2048); kf[3] = *(const LAS h8*)(kp + 2560);
    kf[4] = *(const LAS h8*)(kp + 4096); kf[5] = *(const LAS h8*)(kp + 4608);
    kf[6] = *(const LAS h8*)(kp + 6144); kf[7] = *(const LAS h8*)(kp + 6656);
}
__device__ __forceinline__ void kload2(h8* kf, lds_cptr kp, int j) { kf[2 * j] = *(const LAS h8*)(kp + j * 2048); kf[2 * j + 1] = *(const LAS h8*)(kp + j * 2048 + 512); }
__device__ __forceinline__ s16x4 vtr(lds_cptr p) { return __builtin_bit_cast(s16x4, __builtin_amdgcn_ds_read_tr16_b64_v4i16((LAS v4i16_t*)p)); }
__device__ __forceinline__ float rowmax(const f32x16& p0, const f32x16& p1) {
    float a = max3f(p0[0], p0[1], p1[0]), b = max3f(p0[2], p0[3], p1[1]); a = max3f(a, p1[2], p1[3]);
#pragma unroll
    for (int r = 4; r < 16; r += 4) { a = max3f(a, p0[r], p0[r + 1]); b = max3f(b, p0[r + 2], p0[r + 3]); a = max3f(a, p1[r], p1[r + 1]); b = max3f(b, p1[r + 2], p1[r + 3]); }
    const float m = max2f(a, b);
    auto rr = __builtin_amdgcn_permlane32_swap(__float_as_uint(m), __float_as_uint(m), false, false);
    return max2f(__uint_as_float(rr[0]), __uint_as_float(rr[1]));
}
__device__ __forceinline__ void pv(f32x16* o, int vb, h8 pa0, h8 pa1, h8 pa2, h8 pa3) {
#pragma unroll
    for (int d0 = 0; d0 < 2; ++d0) { s16x4 lo[4], hi[4];
#pragma unroll
        for (int ks = 0; ks < 4; ++ks) {
            asm volatile("ds_read_b64_tr_b16 %0,%1 offset:%c2" : "=&v"(lo[ks]) : "v"(vb), "i"(d0 * 4096 + ks * 1024) : "memory");
            asm volatile("ds_read_b64_tr_b16 %0,%1 offset:%c2" : "=&v"(hi[ks]) : "v"(vb), "i"(d0 * 4096 + ks * 1024 + 512) : "memory"); }
        asm volatile("s_waitcnt lgkmcnt(0)" ::: "memory"); SBAR();
#define FA_PK(k) __builtin_bit_cast(h8, (s16x8){lo[k][0], lo[k][1], lo[k][2], lo[k][3], hi[k][0], hi[k][1], hi[k][2], hi[k][3]})
        o[d0] = __builtin_amdgcn_mfma_f32_32x32x16_f16(pa0, FA_PK(0), o[d0], 0, 0, 0);
        o[d0] = __builtin_amdgcn_mfma_f32_32x32x16_f16(pa1, FA_PK(1), o[d0], 0, 0, 0);
        o[d0] = __builtin_amdgcn_mfma_f32_32x32x16_f16(pa2, FA_PK(2), o[d0], 0, 0, 0);
        o[d0] = __builtin_amdgcn_mfma_f32_32x32x16_f16(pa3, FA_PK(3), o[d0], 0, 0, 0);
#undef FA_PK
    }
}
__device__ __forceinline__ void table_mask(f32x16& p0, f32x16& p1, const LAS float* base) {
#pragma unroll
    for (int g = 0; g < 4; ++g) {
#pragma unroll
        for (int e = 0; e < 4; ++e) { const int r = 4 * g + e; p0[r] += base[e + 8 * g]; p1[r] += base[32 + e + 8 * g]; }

    }
}
__device__ __forceinline__ void past_mask_far(f32x16& p0, f32x16& p1, int t, unsigned selmask, float c31) {
    const float cin = ((selmask >> (t >> 2)) & 1u) != 0u ? c31 : -INFINITY;
#pragma unroll
    for (int r = 0; r < 16; ++r) { p0[r] += cin; p1[r] += cin; }
}
__device__ __forceinline__ void past_mask(f32x16& p0, f32x16& p1, int t, int qt, int wid, int r32, int hi, unsigned selmask, float c31, const LAS float* lutE) {
    const int j = t >> 2, ti = t & 3;
    if (j == qt - 1 && 32 * wid + 193 - 64 * ti < 113) {
        const bool sel = ((selmask >> j) & 1u) != 0u;
        const int dbase = 256 + wid * 32 + r32 - 64 * ti - 4 * hi;
        table_mask(p0, p1, sel ? lutE + (511 - dbase) : lutE + 512);
    } else past_mask_far(p0, p1, t, selmask, c31);
}
__device__ __forceinline__ void band_mask(f32x16& p0, f32x16& p1, int jb, int qrel, int hi, const LAS float* lutE) { table_mask(p0, p1, lutE + (511 - (qrel - 64 * jb - 4 * hi))); }

template <bool MOBA, int THRL>
__device__ __forceinline__ void attn_unit(LAS unsigned char* shm, const half_t* Qu, int QP, const half_t* Kh, const half_t* Vh, int KP, int NT, int qt,
                                          const float* km, const LAS float* lutw, half_t* Yg, const half_t* Zg, float* ssyp,
                                          h8 (&qr)[4], bool qpre, bool resident, const half_t* nextQ, int nextQP) {
    int tid_ = threadIdx.x; asm volatile("" : "+v"(tid_));
    const int tid = tid_, lane = tid & 63, r32 = lane & 31, hi = lane >> 5; const int wid = __builtin_amdgcn_readfirstlane(tid >> 6);
    const half_t* Qw = Qu + (size_t)(wid * 32) * QP;
    const unsigned lds0 = (unsigned)(uintptr_t)shm;
    LAS float* wsf = (LAS float*)(shm + LDS_WS) + wid * 64;
    const half_t* ksrc = Kh + (size_t)lane * KP + wid * 8;
    const half_t* vsrc = Vh + (size_t)(16 * (wid & 3) + (lane >> 2)) * KP + (wid >> 2) * 32 + (lane & 3) * 8;
    const unsigned kdst = lds0 + LDS_K + wid * 1024, vdst = lds0 + LDS_V + wid * 1024;
#define DMA_K(t, slot) glds16(ksrc + (size_t)(t) * KVBLK * KP, (unsigned)__builtin_amdgcn_readfirstlane(kdst + (slot)))
#define DMA_V(t, slot) glds16(vsrc + (size_t)(t) * KVBLK * KP, (unsigned)__builtin_amdgcn_readfirstlane(vdst + (slot)))
    const int vb0 = (int)(lds0 + LDS_V) + ((lane >> 4) & 1) * 32 + (lane & 3) * 8 + (4 * hi + ((lane & 15) >> 2)) * 64;
    const lds_cptr Kbase = shm + LDS_K; h8 kf[8];
    const lds_cptr kp0 = shm + LDS_K + hi * 1024 + r32 * 16; const lds_cptr vp0 = shm + LDS_V + ((lane >> 4) & 1) * 32 + (lane & 3) * 8 + (4 * hi + ((lane & 15) >> 2)) * 64;
    if (!resident) { DMA_K(0, 0); DMA_V(0, 0); DMA_K(1, SLOTB); }
    if (!qpre) {
#pragma unroll
        for (int d0 = 0; d0 < 4; ++d0) qr[d0] = *(const h8*)(Qw + (size_t)r32 * QP + d0 * 16 + hi * 8);
    }
    unsigned selmask = 0u; float c31 = 0.f;
    if (MOBA) {
        c31 = lutw[511 - 127];
        float gs[8];
        if (qt > 0) {
            f32x16 gacc = f32x16{};
#pragma unroll
            for (int d0 = 0; d0 < 4; ++d0) { h8 ka = h8{};
                if (r32 < qt) { const float* kp = km + r32 * 384 + d0 * 16 + hi * 8; const f32x4 k0 = *(const f32x4*)kp, k1 = *(const f32x4*)(kp + 4);
                    u32x4 w; w.x = pkh(k0[0] * (1.0f / 256.0f), k0[1] * (1.0f / 256.0f)); w.y = pkh(k0[2] * (1.0f / 256.0f), k0[3] * (1.0f / 256.0f));
                    w.z = pkh(k1[0] * (1.0f / 256.0f), k1[1] * (1.0f / 256.0f)); w.w = pkh(k1[2] * (1.0f / 256.0f), k1[3] * (1.0f / 256.0f)); ka = __builtin_bit_cast(h8, w); }
                gacc = __builtin_amdgcn_mfma_f32_32x32x16_f16(ka, qr[d0], gacc, 0, 0, 0); }
#pragma unroll
            for (int i = 0; i < 4; ++i) { auto rr = __builtin_amdgcn_permlane32_swap(__float_as_uint(gacc[i]), __float_as_uint(gacc[i]), false, false);
                const float own = gacc[i], oth = hi == 0 ? __uint_as_float(rr[1]) : __uint_as_float(rr[0]);
                gs[i] = hi == 0 ? own : oth; gs[4 + i] = hi == 0 ? oth : own; }
        } else {
#pragma unroll
            for (int j = 0; j < 8; ++j) gs[j] = 0.f;
        }
#pragma unroll
        for (int j = 0; j < 7; ++j) if (j >= qt) gs[j] = -INFINITY;
#pragma unroll
        for (int j = 0; j < 7; ++j) { int cnt = 0;
#pragma unroll
            for (int k = 0; k < 7; ++k) if (k != j) cnt += (k < j ? gs[k] >= gs[j] : gs[k] > gs[j]) ? 1 : 0;
            if (j < qt && cnt < 3) selmask |= 1u << j; }
    }
    float mhat = 0.f, l_reg = 0.f; f32x16 o[2]; o[0] = f32x16{}; o[1] = f32x16{}; f32x16 negm = f32x16{}; asm volatile("" : "+v"(negm));
    const int qrel = wid * 32 + r32;
#define CMASK(P0, P1, t) do { if (MOBA) { const int jb_ = (t) - (NT - 4); if (jb_ >= 0) band_mask(P0, P1, jb_, qrel, hi, lutw); else past_mask(P0, P1, (t), qt, wid, r32, hi, selmask, c31, lutw); } } while (0)
    bool resc = false;
#define START(P0, P1) do { const float rm = max2f(rowmax(P0, P1), -1000.0f); resc = false; \
    { const float dl = rm; mhat = fadd_s(mhat, dl); \
      _Pragma("unroll") for (int r = 0; r < 16; ++r) { P0[r] = fsub_s(P0[r], dl); P1[r] = fsub_s(P1[r], dl); } \
      _Pragma("unroll") for (int r = 0; r < 16; ++r) negm[r] = -mhat; asm volatile("" : "+v"(negm)); } \
    _Pragma("unroll") for (int r = 0; r < 16; ++r) P0[r] = __builtin_amdgcn_exp2f(P0[r]); } while (0)
#define RESC() do { if (resc) { asm volatile("s_waitcnt lgkmcnt(0)" ::: "memory"); \
      _Pragma("unroll") for (int d_ = 0; d_ < 2; ++d_) _Pragma("unroll") for (int r = 0; r < 16; ++r) o[d_][r] *= wsf[crow(r, hi)]; } } while (0)
    f32x16 pA0, pA1, pB0, pB1;
#define ROT() do { } while (0)
    if (!resident) DMA_K(2, 2 * SLOTB);
    WAIT_BAR(3);
    qkt(pA0, pA1, Kbase, qr, negm, r32, hi); asm volatile("s_nop 15\n\ts_nop 7" : "+v"(pA0), "+v"(pA1)); CMASK(pA0, pA1, 0);
    START(pA0, pA1);
    _Pragma("unroll") for (int r = 0; r < 16; ++r) pA1[r] = __builtin_amdgcn_exp2f(pA1[r]);
    WAIT_BAR(0);
    if (!resident) { DMA_K(3, 3 * SLOTB); DMA_V(1, SLOTB); DMA_V(2, 2 * SLOTB); }
    kload8(kf, kp0 + SLOTB);
    WAIT_BAR(3);
    s16x4 vlo[8], vhi[8]; u32x4 pw0, pw1, pw2, pw3;
#define PKW(P, B) pkh(P[B], P[B + 1])
#define PAF(k) __builtin_bit_cast(h8, pw##k)
#define VFR(i) __builtin_bit_cast(h8, (s16x8){vlo[i][0], vlo[i][1], vlo[i][2], vlo[i][3], vhi[i][0], vhi[i][1], vhi[i][2], vhi[i][3]})
#define PIN(x) asm volatile("" : "+v"(x))
#define MX3(a, b, c) __builtin_fmaxf(__builtin_fmaxf((a), (b)), (c))
#define GAPA(MF, A0, A1, A2, A3, W0, W1, PW) do { MF; sacc += A0; sacc += A1; sacc += A2; sacc += A3; PIN(sacc); W0; W1; PIN(PW); SBAR(); } while (0)
#define EX(v) __builtin_amdgcn_exp2f(v)
#define GAPB(MF, X, B) do { MF; X[B] = EX(X[B]); X[B + 1] = EX(X[B + 1]); X[B + 2] = EX(X[B + 2]); X[B + 3] = EX(X[B + 3]); PIN(X); SBAR(); } while (0)
#define VRD(i) do { vlo[i] = vtr(vp_ + (((i) >> 2) * 4096 + ((i) & 3) * 1024)); vhi[i] = vtr(vp_ + (((i) >> 2) * 4096 + ((i) & 3) * 1024 + 512)); } while (0)
#define KRD(G, j, t) do { if (G) { kload2(kf, kp0 + ((((t) + 1) & 3) * SLOTB), j); SBAR(); } } while (0)
#define MF16 __builtin_amdgcn_mfma_f32_32x32x16_f16
#define STEP(C0, C1, P0, P1, t, GK, GV, GL) do { SBAR(); \
    const lds_cptr vp_ = vp0 + ((((t) - 1) & 3) * SLOTB); \
    VRD(0); SBAR(); float sacc = (P0[0] + P0[1]); \
    GAPA(C0 = MF16(kf[0], qr[0], negm, 0, 0, 0), P0[2], P0[3], P0[4], P0[5],     pw0[0] = PKW(P0, 0), pw0[1] = PKW(P0, 2), pw0); \
    VRD(4); SBAR(); GAPA(C1 = MF16(kf[1], qr[0], negm, 0, 0, 0), P0[6], P0[7], P0[8], P0[9],     pw0[2] = PKW(P0, 4), pw0[3] = PKW(P0, 6), pw0); \
    VRD(1); SBAR(); GAPA(C0 = MF16(kf[2], qr[1], C0, 0, 0, 0),   P0[10], P0[11], P0[12], P0[13], pw1[0] = PKW(P0, 8), pw1[1] = PKW(P0, 10), pw1); \
    VRD(5); SBAR(); GAPA(C1 = MF16(kf[3], qr[1], C1, 0, 0, 0),   P0[14], P0[15], P1[0], P1[1],   pw1[2] = PKW(P0, 12), pw1[3] = PKW(P0, 14), pw1); \
    VRD(2); SBAR(); GAPA(C0 = MF16(kf[4], qr[2], C0, 0, 0, 0),   P1[2], P1[3], P1[4], P1[5],     pw2[0] = PKW(P1, 0), pw2[1] = PKW(P1, 2), pw2); \
    VRD(6); SBAR(); GAPA(C1 = MF16(kf[5], qr[2], C1, 0, 0, 0),   P1[6], P1[7], P1[8], P1[9],     pw2[2] = PKW(P1, 4), pw2[3] = PKW(P1, 6), pw2); \
    VRD(3); SBAR(); GAPA(C0 = MF16(kf[6], qr[3], C0, 0, 0, 0),   P1[10], P1[11], P1[12], P1[13], pw3[0] = PKW(P1, 8), pw3[1] = PKW(P1, 10), pw3); \
    VRD(7); SBAR(); GAPA(C1 = MF16(kf[7], qr[3], C1, 0, 0, 0),   P1[14], P1[15], 0.f, 0.f,       pw3[2] = PKW(P1, 12), pw3[3] = PKW(P1, 14), pw3); \
    l_reg += sacc; \
    if ((GK) && !resident) { DMA_K((t) + 3, (((t) + 3) & 3) * SLOTB); } if ((GV) && !resident) { DMA_V((t) + 2, (((t) + 2) & 3) * SLOTB); } \
    CMASK(C0, C1, t); \
    { float a = MX3(C0[0], C0[1], C1[0]), b = MX3(C0[2], C0[3], C1[1]); a = MX3(a, C1[2], C1[3]); \
      _Pragma("unroll") for (int r = 4; r < 16; r += 4) { a = MX3(a, C0[r], C0[r + 1]); b = MX3(b, C0[r + 2], C0[r + 3]); a = MX3(a, C1[r], C1[r + 1]); b = MX3(b, C1[r + 2], C1[r + 3]); } \
      float rm = __builtin_fmaxf(a, b); { auto rr = __builtin_amdgcn_permlane32_swap(__float_as_uint(rm), __float_as_uint(rm), false, false); rm = __builtin_fmaxf(__uint_as_float(rr[0]), __uint_as_float(rr[1])); } \
      resc = false; \
      if (__builtin_expect(__any(rm > (float)THRL), 0)) { const float dl = __builtin_fmaxf(rm, 0.f); mhat += dl; \
        _Pragma("unroll") for (int r = 0; r < 16; ++r) { C0[r] -= dl; C1[r] -= dl; } \
        _Pragma("unroll") for (int r = 0; r < 16; ++r) negm[r] = -mhat; asm volatile("" : "+v"(negm)); \
        const float f = __builtin_amdgcn_exp2f(-dl); l_reg *= f; if (hi == 0) wsf[r32] = f; resc = true; } } \
    SBAR(); \
    GAPB(o[0] = MF16(PAF(0), VFR(0), o[0], 0, 0, 0), C0, 0); \
    GAPB(o[1] = MF16(PAF(0), VFR(4), o[1], 0, 0, 0), C0, 4); \
    KRD(GL, 0, t); GAPB(o[0] = MF16(PAF(1), VFR(1), o[0], 0, 0, 0), C0, 8); \
    KRD(GL, 1, t); GAPB(o[1] = MF16(PAF(1), VFR(5), o[1], 0, 0, 0), C0, 12); \
    KRD(GL, 2, t); GAPB(o[0] = MF16(PAF(2), VFR(2), o[0], 0, 0, 0), C1, 0); \
    KRD(GL, 3, t); GAPB(o[1] = MF16(PAF(2), VFR(6), o[1], 0, 0, 0), C1, 4); \
    GAPB(o[0] = MF16(PAF(3), VFR(3), o[0], 0, 0, 0), C1, 8); \
    GAPB(o[1] = MF16(PAF(3), VFR(7), o[1], 0, 0, 0), C1, 12); \
    } while (0)
    int t = 1;
#undef CMASK
#define CMASK(P0, P1, t) do { if (MOBA) past_mask_far(P0, P1, (t), selmask, c31); } while (0)
    for (; t + 7 < NT; t += 2) {
        STEP(pB0, pB1, pA0, pA1, t, true, true, true);     WAIT_BAR(3); RESC(); ROT();
        STEP(pA0, pA1, pB0, pB1, t + 1, true, true, true); WAIT_BAR(3); RESC(); ROT();
    }
#undef CMASK
#define CMASK(P0, P1, t) do { if (MOBA) { const int jb_ = (t) - (NT - 4); if (jb_ >= 0) band_mask(P0, P1, jb_, qrel, hi, lutw); else past_mask(P0, P1, (t), qt, wid, r32, hi, selmask, c31, lutw); } } while (0)
#define ENDW(tt) do { if ((tt) + 3 < NT) { WAIT_BAR(3); } else if ((tt) + 2 < NT) { WAIT_BAR(2); } else { WAIT_BAR(0); } } while (0)
    for (; t + 1 < NT; t += 2) {
        STEP(pB0, pB1, pA0, pA1, t, (t + 3 < NT), (t + 2 < NT), (t + 1 < NT));     ENDW(t);     RESC(); ROT();
        STEP(pA0, pA1, pB0, pB1, t + 1, (t + 4 < NT), (t + 3 < NT), (t + 2 < NT)); ENDW(t + 1); RESC(); ROT();
    }
    STEP(pB0, pB1, pA0, pA1, NT - 1, false, false, false); RESC();
    if (nextQ) {
        const half_t* nq = nextQ + (size_t)(wid * 32 + r32) * nextQP + hi * 8;
#pragma unroll
        for (int d0 = 0; d0 < 4; ++d0) qr[d0] = *(const h8*)(nq + d0 * 16);
    }
    h8 zv[4];
    { const half_t* zp = Zg + (size_t)(wid * 32 + (lane >> 1)) * PP + (lane & 1) * 32;
#pragma unroll
      for (int c = 0; c < 4; ++c) zv[c] = *(const h8*)(zp + c * 8); }
    { float sacc = pB0[0] + pB0[1]; _Pragma("unroll") for (int r = 2; r < 16; ++r) sacc += pB0[r]; _Pragma("unroll") for (int r = 0; r < 16; ++r) sacc += pB1[r]; l_reg += sacc;
      pw0 = (u32x4){PKW(pB0, 0), PKW(pB0, 2), PKW(pB0, 4), PKW(pB0, 6)}; pw1 = (u32x4){PKW(pB0, 8), PKW(pB0, 10), PKW(pB0, 12), PKW(pB0, 14)}; pw2 = (u32x4){PKW(pB1, 0), PKW(pB1, 2), PKW(pB1, 4), PKW(pB1, 6)}; pw3 = (u32x4){PKW(pB1, 8), PKW(pB1, 10), PKW(pB1, 12), PKW(pB1, 14)};
      SBAR(); pv(o, vb0 + ((NT - 1) & 3) * SLOTB, PAF(0), PAF(1), PAF(2), PAF(3)); }
#undef PKW
#undef PAF
#undef VFR
#undef PIN
#undef MX3
#undef GAPA
#undef GAPB
#undef EX
#undef VRD
#undef KRD
#undef MF16
#undef STEP
#undef ENDW
    { auto rr = __builtin_amdgcn_permlane32_swap(__float_as_uint(l_reg), __float_as_uint(l_reg), false, false); l_reg = __uint_as_float(rr[0]) + __uint_as_float(rr[1]); }
    if (hi == 0) wsf[32 + r32] = __builtin_amdgcn_rcpf(l_reg);
    LAS float* stg = (LAS float*)(shm + LDS_STG + wid * STG_W);
#pragma unroll
    for (int r = 0; r < 16; ++r) { const int q = crow(r, hi); stg[q * STG_ROW + r32] = o[0][r]; stg[q * STG_ROW + 32 + r32] = o[1][r]; }
    asm volatile("s_waitcnt lgkmcnt(0)" ::: "memory");
    { const int row = lane >> 1, hf = lane & 1; const LAS float* sp = stg + row * STG_ROW + hf * 32; const float inv = wsf[32 + row];
      half_t* yp = Yg + (size_t)(wid * 32 + row) * DM + hf * 32; float ss = 0.f; f32x2 ss2 = {0.f, 0.f};
#pragma unroll
      for (int c = 0; c < 4; ++c) { const f32x4 v0 = *(const LAS f32x4*)(sp + c * 8) * inv, v1 = *(const LAS f32x4*)(sp + c * 8 + 4) * inv; const h8 z = zv[c];
          ss2 = (f32x2){v0[0], v0[1]} * (f32x2){v0[0], v0[1]} + ss2; ss2 = (f32x2){v0[2], v0[3]} * (f32x2){v0[2], v0[3]} + ss2;
          ss2 = (f32x2){v1[0], v1[1]} * (f32x2){v1[0], v1[1]} + ss2; ss2 = (f32x2){v1[2], v1[3]} * (f32x2){v1[2], v1[3]} + ss2;
          u32x4 w; w.x = pkh(v0[0] * (float)z[0], v0[1] * (float)z[1]); w.y = pkh(v0[2] * (float)z[2], v0[3] * (float)z[3]);
          w.z = pkh(v1[0] * (float)z[4], v1[1] * (float)z[5]); w.w = pkh(v1[2] * (float)z[6], v1[3] * (float)z[7]);
          *(u32x4*)(yp + c * 8) = w; }
      ss = ss2.x + ss2.y;
      ss += __shfl_xor(ss, 1);
      if (hf == 0) ssyp[(size_t)(wid * 32 + row) * 16] = ss; }
    asm volatile("s_waitcnt lgkmcnt(0)\n\ts_barrier" ::: "memory");
#undef DMA_K
#undef DMA_V
#undef CMASK
#undef START
#undef RESC
#undef ROT
}
#undef SBAR
#undef WAIT_BAR
}

__device__ __forceinline__ void gmlp_unit(LAS unsigned char* lds, int tid, const half_t* proj, const half_t* wsp_lg, const float* lng, const float* lnb, const float* spb, half_t* Y, float* ssy, int bc2, int g) {
    asm volatile("" : "+v"(tid));
    const int lane = tid & 63, wid = __builtin_amdgcn_readfirstlane(tid >> 6);
    const int r0 = bc2 * 256;
    const int s = tid >> 2, qd = tid & 3;
    const int tl = lane >> 2, cq = lane & 3, t = 16 * wid + tl;
    h8 vv[2][2], uu[2][2], zz[2][2];
#pragma unroll
    for (int c = 0; c < 2; ++c) { const half_t* vp = proj + (size_t)(r0 + c * 128 + s) * PP + C_V + g * 64 + qd * 16; vv[c][0] = *(const h8*)vp; vv[c][1] = *(const h8*)(vp + 8); }
#pragma unroll
    for (int c = 0; c < 2; ++c) { const half_t* up = proj + (size_t)(r0 + c * 128 + t) * PP + C_U + g * 64 + cq * 16; const half_t* zp = proj + (size_t)(r0 + c * 128 + t) * PP + C_Z + g * 64 + cq * 16;
        uu[c][0] = *(const h8*)up; uu[c][1] = *(const h8*)(up + 8); zz[c][0] = *(const h8*)zp; zz[c][1] = *(const h8*)(zp + 8); }
    float lg[16], lb[16];
#pragma unroll
    for (int e = 0; e < 16; ++e) { lg[e] = lng[qd * 16 + e]; lb[e] = lnb[qd * 16 + e]; }
    const int r16 = lane & 15, kq = lane >> 4;
    const int nks = (16 * wid + 15) / 32 + 1;
    h8 af[4];
#pragma unroll
    for (int ks = 0; ks < 4; ++ks) af[ks] = *(const h8*)(wsp_lg + (size_t)(16 * wid + r16) * 128 + (ks < nks ? ks : 0) * 32 + kq * 8);
    const float bsp = spb[t];
#pragma unroll
    for (int c = 0; c < 2; ++c) {
        LAS half_t* vnt = (LAS half_t*)(lds + GM_VNT + c * GM_VNT_BYTES);
        float x[16]; float sum = 0.f;
#pragma unroll
        for (int e = 0; e < 8; ++e) { x[e] = (float)vv[c][0][e]; x[8 + e] = (float)vv[c][1][e]; }
#pragma unroll
        for (int e = 0; e < 16; ++e) sum += x[e];
        sum += __shfl_xor(sum, 1); sum += __shfl_xor(sum, 2);
        const float mu = sum * (1.0f / 64.0f); float var = 0.f;
#pragma unroll
        for (int e = 0; e < 16; ++e) { x[e] -= mu; var += x[e] * x[e]; }
        var += __shfl_xor(var, 1); var += __shfl_xor(var, 2);
        const float rs = __builtin_amdgcn_rsqf(var * (1.0f / 64.0f) + EPS);
#pragma unroll
        for (int e = 0; e < 16; ++e) vnt[(qd * 16 + e) * GM_VNT_ROW + s] = (half_t)(x[e] * rs * lg[e] + lb[e]);
    }
    __syncthreads();
    f32x4 acc[2][4];
#pragma unroll
    for (int c = 0; c < 2; ++c)
#pragma unroll
        for (int n = 0; n < 4; ++n) acc[c][n] = (f32x4){0.f, 0.f, 0.f, 0.f};
#pragma unroll
    for (int ks = 0; ks < 4; ++ks) {
        if (ks < nks) {
#pragma unroll
            for (int c = 0; c < 2; ++c)
#pragma unroll
                for (int n = 0; n < 4; ++n) { const h8 bf = *(const LAS h8*)(lds + GM_VNT + c * GM_VNT_BYTES + ((16 * n + r16) * GM_VNT_ROW + ks * 32 + kq * 8) * 2);
                    acc[c][n] = __builtin_amdgcn_mfma_f32_16x16x32_f16(af[ks], bf, acc[c][n], 0, 0, 0); }
        }
    }
#pragma unroll
    for (int c = 0; c < 2; ++c) {
        LAS float* stg = (LAS float*)(lds + GM_STAGE) + (c * 8 + wid) * 16 * AT_STG_ROW;
#pragma unroll
        for (int n = 0; n < 4; ++n)
#pragma unroll
            for (int e = 0; e < 4; ++e) stg[(4 * kq + e) * AT_STG_ROW + 16 * n + r16] = acc[c][n][e];
    }
    asm volatile("s_waitcnt lgkmcnt(0)" ::: "memory");
#pragma unroll
    for (int c = 0; c < 2; ++c) {
        const LAS float* sp = (const LAS float*)(lds + GM_STAGE) + (c * 8 + wid) * 16 * AT_STG_ROW + tl * AT_STG_ROW + cq * 16;
        const int row = r0 + c * 128 + t; half_t* yp = Y + (size_t)row * DM + g * 64 + cq * 16; float ss = 0.f;
#pragma unroll
        for (int k = 0; k < 2; ++k) { const f32x4 s0 = *(const LAS f32x4*)(sp + k * 8), s1 = *(const LAS f32x4*)(sp + k * 8 + 4); const h8 u = uu[c][k], z = zz[c][k]; float yv[8];
#pragma unroll
            for (int e = 0; e < 4; ++e) { yv[e] = (float)u[e] * (s0[e] + bsp); yv[4 + e] = (float)u[4 + e] * (s1[e] + bsp); }
#pragma unroll
            for (int e = 0; e < 8; ++e) ss += yv[e] * yv[e];
            u32x4 w; w.x = pkh(yv[0] * (float)z[0], yv[1] * (float)z[1]); w.y = pkh(yv[2] * (float)z[2], yv[3] * (float)z[3]);
            w.z = pkh(yv[4] * (float)z[4], yv[5] * (float)z[5]); w.w = pkh(yv[6] * (float)z[6], yv[7] * (float)z[7]);
            *(u32x4*)(yp + k * 8) = w; }
        ss += __shfl_xor(ss, 1); ss += __shfl_xor(ss, 2);
        if (cq == 0) ssy[(size_t)row * 16 + g] = ss;
    }
    __syncthreads();
}

__device__ __forceinline__ void gmlp_chain3(LAS unsigned char* lds, int tid, const half_t* proj, const half_t* wsp_l, const float* lng_l, const float* lnb_l, const float* spb_l, half_t* Y, float* ssy, int grp, int rank) {
    asm volatile("" : "+v"(tid));
    const int lane = tid & 63, wid = __builtin_amdgcn_readfirstlane(tid >> 6);
    const int s = tid >> 2, qd = tid & 3;
    const int tl = lane >> 2, cq = lane & 3, t = 16 * wid + tl;
    const int r16 = lane & 15, kq = lane >> 4;
    const int nks = (16 * wid + 15) / 32 + 1;
    h8 vv[2][2], uu[2][2], zz[2][2], af[4], afn[4]; float lg[16], lb[16]; float bsp;
#define GM_UNIT(k) const int ug_ = rank * 3 + (k), g_ = ug_ >> 4, r0_ = (16 * grp + (ug_ & 15)) * 256
#define GM_LOADV(k, AF) do { GM_UNIT(k); \
        _Pragma("unroll") for (int c = 0; c < 2; ++c) { const half_t* vp = proj + (size_t)(r0_ + c * 128 + s) * PP + C_V + g_ * 64 + qd * 16; vv[c][0] = *(const h8*)vp; vv[c][1] = *(const h8*)(vp + 8); } \
        _Pragma("unroll") for (int e = 0; e < 16; ++e) { lg[e] = lng_l[g_ * 64 + qd * 16 + e]; lb[e] = lnb_l[g_ * 64 + qd * 16 + e]; } \
        _Pragma("unroll") for (int ks = 0; ks < 4; ++ks) AF[ks] = *(const h8*)(wsp_l + (size_t)g_ * 128 * 128 + (size_t)(16 * wid + r16) * 128 + (ks < nks ? ks : 0) * 32 + kq * 8); } while (0)
#define GM_LOADUZ(k) do { GM_UNIT(k); \
        _Pragma("unroll") for (int c = 0; c < 2; ++c) { const half_t* up = proj + (size_t)(r0_ + c * 128 + t) * PP + C_U + g_ * 64 + cq * 16; const half_t* zp = proj + (size_t)(r0_ + c * 128 + t) * PP + C_Z + g_ * 64 + cq * 16; \
            uu[c][0] = *(const h8*)up; uu[c][1] = *(const h8*)(up + 8); zz[c][0] = *(const h8*)zp; zz[c][1] = *(const h8*)(zp + 8); } \
        bsp = spb_l[g_ * 128 + t]; } while (0)
    GM_LOADV(0, af); GM_LOADUZ(0);
#pragma unroll
    for (int k = 0; k < 3; ++k) {
        GM_UNIT(k);
#pragma unroll
        for (int c = 0; c < 2; ++c) {
            LAS half_t* vnt = (LAS half_t*)(lds + GM_VNT + c * GM_VNT_BYTES);
            float x[16]; float sum = 0.f;
#pragma unroll
            for (int e = 0; e < 8; ++e) { x[e] = (float)vv[c][0][e]; x[8 + e] = (float)vv[c][1][e]; }
#pragma unroll
            for (int e = 0; e < 16; ++e) sum += x[e];
            sum += __shfl_xor(sum, 1); sum += __shfl_xor(sum, 2);
            const float mu = sum * (1.0f / 64.0f); float var = 0.f;
#pragma unroll
            for (int e = 0; e < 16; ++e) { x[e] -= mu; var += x[e] * x[e]; }
            var += __shfl_xor(var, 1); var += __shfl_xor(var, 2);
            const float rs = __builtin_amdgcn_rsqf(var * (1.0f / 64.0f) + EPS);
#pragma unroll
            for (int e = 0; e < 16; ++e) vnt[(qd * 16 + e) * GM_VNT_ROW + s] = (half_t)(x[e] * rs * lg[e] + lb[e]);
        }
        __syncthreads();
        if (k < 2) GM_LOADV(k + 1, afn);
        f32x4 acc[2][4];
#pragma unroll
        for (int c = 0; c < 2; ++c)
#pragma unroll
            for (int n = 0; n < 4; ++n) acc[c][n] = (f32x4){0.f, 0.f, 0.f, 0.f};
#pragma unroll
        for (int ks = 0; ks < 4; ++ks) {
            if (ks < nks) {
#pragma unroll
                for (int c = 0; c < 2; ++c)
#pragma unroll
                    for (int n = 0; n < 4; ++n) { const h8 bf = *(const LAS h8*)(lds + GM_VNT + c * GM_VNT_BYTES + ((16 * n + r16) * GM_VNT_ROW + ks * 32 + kq * 8) * 2);
                        acc[c][n] = __builtin_amdgcn_mfma_f32_16x16x32_f16(af[ks], bf, acc[c][n], 0, 0, 0); }
            }
        }
#pragma unroll
        for (int c = 0; c < 2; ++c) {
            LAS float* stg = (LAS float*)(lds + GM_STAGE) + (c * 8 + wid) * 16 * AT_STG_ROW;
#pragma unroll
            for (int n = 0; n < 4; ++n)
#pragma unroll
                for (int e = 0; e < 4; ++e) stg[(4 * kq + e) * AT_STG_ROW + 16 * n + r16] = acc[c][n][e];
        }
        asm volatile("s_waitcnt lgkmcnt(0)" ::: "memory");
#pragma unroll
        for (int c = 0; c < 2; ++c) {
            const LAS float* sp = (const LAS float*)(lds + GM_STAGE) + (c * 8 + wid) * 16 * AT_STG_ROW + tl * AT_STG_ROW + cq * 16;
            const int row = r0_ + c * 128 + t; half_t* yp = Y + (size_t)row * DM + g_ * 64 + cq * 16; float ss = 0.f;
#pragma unroll
            for (int j = 0; j < 2; ++j) { const f32x4 s0 = *(const LAS f32x4*)(sp + j * 8), s1 = *(const LAS f32x4*)(sp + j * 8 + 4); const h8 u = uu[c][j], z = zz[c][j]; float yv[8];
#pragma unroll
                for (int e = 0; e < 4; ++e) { yv[e] = (float)u[e] * (s0[e] + bsp); yv[4 + e] = (float)u[4 + e] * (s1[e] + bsp); }
#pragma unroll
                for (int e = 0; e < 8; ++e) ss += yv[e] * yv[e];
                u32x4 w; w.x = pkh(yv[0] * (float)z[0], yv[1] * (float)z[1]); w.y = pkh(yv[2] * (float)z[2], yv[3] * (float)z[3]);
                w.z = pkh(yv[4] * (float)z[4], yv[5] * (float)z[5]); w.w = pkh(yv[6] * (float)z[6], yv[7] * (float)z[7]);
                *(u32x4*)(yp + j * 8) = w; }
            ss += __shfl_xor(ss, 1); ss += __shfl_xor(ss, 2);
            if (cq == 0) ssy[(size_t)row * 16 + g_] = ss;
        }
        if (k < 2) { GM_LOADUZ(k + 1);
#pragma unroll
            for (int ks = 0; ks < 4; ++ks) af[ks] = afn[ks]; }
        __syncthreads();
    }
#undef GM_UNIT
#undef GM_LOADV
#undef GM_LOADUZ
}

constexpr int NU_MOBA = 96 * 8, NU_MEM = 64 * 8, NU_GMLP = 128 * 6, NU_ALL = NU_MOBA + NU_MEM + NU_GMLP;
__device__ __forceinline__ void mixer_phase_fast(Frame& F, const Args& a, int l, int qidx) {
    static_assert(fa::LDS_END <= MISC_OFF, "attention LDS map");
    LAS float* lut = (LAS float*)(F.lds + fa::LDS_LUT);
    { const f32x4* src = (const f32x4*)(a.ws + WS_LUT); static_assert(fa::LUT_N == 768, "table size");
      for (int i = F.tid; i < 6 * fa::LUT_N / 4; i += NTHR) ((LAS f32x4*)lut)[i] = src[i]; }
    __syncthreads();
    volatile LAS unsigned* MISC = (volatile LAS unsigned*)(F.lds + MISC_OFF);
    const bool deal = F.G == 256;
    const int grp = F.bid & 7;
    unsigned* qhead = F.ctl + CW_QUEUE + 64 * (deal ? qidx * 8 + grp : 24 + qidx);
    const half_t* mkv_l = F.mkv + (size_t)l * MMEM * NKV;
    const int vcu = (F.bid & 7) * 32 + (F.bid >> 3);
    h8 qr[4] = {};
    for (int it = 0;; ++it) {
        int u;
        if (deal && it < 5) {
            if (it < 3) { const int gi = vcu >> 3, tri = vcu & 7; int bsel, qt;
                if (tri < 6) { bsel = tri >> 1; qt = (tri & 1) ? (it == 0 ? 6 : (it == 1 ? 5 : 0)) : (it == 0 ? 7 : (it == 1 ? 2 : 1)); }
                else if (tri == 6) { bsel = it == 1 ? 1 : 0; qt = it == 2 ? 3 : 4; }
                else { bsel = it == 1 ? 1 : 2; qt = it == 0 ? 4 : 3; }
                u = (7 - qt) * 96 + 3 * gi + bsel; }
            else u = NU_MOBA + (vcu >> 2) * 8 + 2 * (vcu & 3) + (it - 3);
        } else if (deal) {
            gmlp_chain3(F.lds, F.tid, F.proj, F.wsp + (size_t)l * 6 * 128 * 128, a.ln_g + l * 384, a.ln_b + l * 384, a.sp_b + l * 6 * 128, F.y, F.ssy, grp, vcu & 31);
            break;
        } else {
            if (F.tid == 0) MISC[16] = __hip_atomic_fetch_add(qhead, 1u, __ATOMIC_RELAXED, __HIP_MEMORY_SCOPE_AGENT);
            __syncthreads();
            u = __builtin_amdgcn_readfirstlane((int)MISC[16]);
            if (u >= NU_ALL) break;
        }
        if (u < NU_MOBA) {
            const int qt = 7 - u / 96, bh = u % 96, b = bh / 6, h = bh % 6; const size_t row0 = (size_t)b * SEQ + qt * 256;
            fa::attn_unit<true, 8>(F.lds, F.proj + row0 * PP + C_QB + h * 64, PP, F.proj + (size_t)b * SEQ * PP + C_KB + h * 64, F.proj + (size_t)b * SEQ * PP + C_VB + h * 64, PP, 4 * qt + 4, qt,
                                   F.kmean + (size_t)(b * 8) * 384 + h * 64, lut + h * fa::LUT_N, F.y + row0 * DM + 384 + h * 64, F.proj + row0 * PP + C_Z + 384 + h * 64, F.ssy + row0 * 16 + 6 + h, qr, false, false, nullptr, 0);
        } else if (u < NU_MOBA + NU_MEM) {
            const int v = u - NU_MOBA, b = v >> 5, h = (v >> 3) & 3, qt = v & 7; const size_t row0 = (size_t)b * SEQ + qt * 256;
            const bool pair1 = deal && it == 3, pair2 = deal && it == 4;
            fa::attn_unit<false, 8>(F.lds, F.proj + row0 * PP + C_QM + h * 64, PP, mkv_l + (size_t)b * MEML * NKV + h * 64, mkv_l + (size_t)b * MEML * NKV + 256 + h * 64, NKV, 4, 0,
                                    nullptr, lut, F.y + row0 * DM + 768 + h * 64, F.proj + row0 * PP + C_Z + 768 + h * 64, F.ssy + row0 * 16 + 12 + h,
                                    qr, pair2, pair2, pair1 ? F.proj + (row0 + 256) * PP + C_QM + h * 64 : nullptr, PP);
        } else {
            const int v = u - NU_MOBA - NU_MEM, g = v >> 7, bc = v & 127;
            gmlp_unit(F.lds, F.tid, F.proj, F.wsp + (size_t)(l * 6 + g) * 128 * 128, a.ln_g + l * 384 + g * 64, a.ln_b + l * 384 + g * 64, a.sp_b + (l * 6 + g) * 128, F.y, F.ssy, bc, g);
        }
    }
}

__device__ __forceinline__ void ynorm_phase(Frame& F) {
    const int gw = F.bid * NWAVES + F.wave, NGW = F.G * NWAVES;
    for (int m = gw; m < MTOK; m += NGW) {
        const float* sp = F.ssy + (size_t)m * 16;
        const int br = F.lane < 24 ? 0 : (F.lane < 48 ? 1 : 2);
        float s = 0.f;
        if (br == 0) s = ((sp[0] + sp[1]) + (sp[2] + sp[3])) + (sp[4] + sp[5]);
        else if (br == 1) s = ((sp[6] + sp[7]) + (sp[8] + sp[9])) + (sp[10] + sp[11]);
        else s = (sp[12] + sp[13]) + (sp[14] + sp[15]);
        const float rs = __builtin_amdgcn_rsqf(s * (br == 2 ? 1.0f / 256.0f : 1.0f / 384.0f) + EPS);
        h8* yp = (h8*)(F.y + (size_t)m * DM + F.lane * 16);
#pragma unroll
        for (int c = 0; c < 2; ++c) { h8 v = yp[c];
#pragma unroll
            for (int e = 0; e < 8; ++e) v[e] = (half_t)((float)v[e] * rs);
            yp[c] = v; }
    }
}
__device__ __forceinline__ void final_phase(Frame& F, const Args& a, float* dst) {
    const bool deal = (F.G & 7) == 0;
    const int gw = deal ? (F.bid >> 3) * NWAVES + F.wave : F.bid * NWAVES + F.wave, NGW = deal ? (F.G >> 3) * NWAVES : F.G * NWAVES;
    const int rbase = deal ? (F.bid & 7) * (MTOK / 8) : 0, rend = deal ? rbase + MTOK / 8 : MTOK;
    const float* ss2 = F.ssx + 2 * MTOK;
    const f32x4* gp = (const f32x4*)a.fin_g + 2 * F.lane; f32x4 g[2][2];
#pragma unroll
    for (int j = 0; j < 2; ++j) { g[j][0] = gp[128 * j]; g[j][1] = gp[128 * j + 1]; }
    for (int m0 = rbase + gw * 8; m0 < rend; m0 += NGW * 8) {
        h8 v[8][2]; float rs[8];
#pragma unroll
        for (int i = 0; i < 8; ++i) { const h8* xp = (const h8*)(F.xh + (size_t)(m0 + i) * DM) + F.lane; rs[i] = ss2[m0 + i]; v[i][0] = __builtin_nontemporal_load(xp); v[i][1] = __builtin_nontemporal_load(xp + 64); }
#pragma unroll
        for (int i = 0; i < 8; ++i) { f32x4* op = (f32x4*)(dst + (size_t)(m0 + i) * DM) + 2 * F.lane; const float r = __builtin_amdgcn_rsqf(rs[i] * (1.0f / DM) + EPS);
#pragma unroll
            for (int j = 0; j < 2; ++j) { const h8 x = v[i][j];
                __builtin_nontemporal_store((f32x4){(float)x[0], (float)x[1], (float)x[2], (float)x[3]} * r * g[j][0], op + 128 * j);
                __builtin_nontemporal_store((f32x4){(float)x[4], (float)x[5], (float)x[6], (float)x[7]} * r * g[j][1], op + 128 * j + 1); } }
    }
}

#define MIXER_PHASE mixer_phase_fast
constexpr int N_PHASES = 8;
__global__ void __launch_bounds__(NTHR, 2) fwd_kernel(Args a_unused) {
    extern __shared__ __attribute__((aligned(16))) unsigned char lds_raw[];
    LAS unsigned char* lds = (LAS unsigned char*)lds_raw;
    volatile LAS unsigned* MISC = (volatile LAS unsigned*)(lds + MISC_OFF);
    for (int u = threadIdx.x; u < 64; u += NTHR) MISC[u] = 0u;
    __syncthreads();
    XcdBarrier bar; GrpBarrier gbar;
    { const Args a = load_args(); bar = xcd_barrier_post((unsigned*)(a.ws + WS_CTL) + CW_BAR, MISC + 8); gbar = grp_barrier_post((unsigned*)(a.ws + WS_CTL), MISC + 10); }
    const bool grouped = (gridDim.x & 7u) == 0u;
#define IN(k) (kargs()->ph_lo <= (k) && (k) < kargs()->ph_hi)
#define SEAM(k) do { if (IN(k) && IN((k) + 1)) { if ((k) > 0 && grouped) grp_barrier(gbar); else xcd_barrier(bar); } } while (0)
    if (IN(0)) { const Args a = load_args(); Frame F = make_frame(lds, a); p0_prologue(F, a);
    } SEAM(0);
    for (int l = 0; l < 2; ++l) {
        const int pb = 3 * l;
        if (IN(pb + 1)) {
            const Args a = load_args(); Frame F = make_frame(lds, a);
            pg8::Gemm g{F.xh, F.bt1 + (size_t)l * NB1 * DM, DM, nullptr}; pg8::Order1 S{F.G, F.bid};
            pg8::EpiProj E{F.proj, F.mkv + (size_t)l * MMEM * NKV, F.ssx + (size_t)l * MTOK, F.kmean + (size_t)l * 128 * 384};
            pg8::gemm_phase<pg8::EpiProj, pg8::Order1, false>(lds, g, S, E);
        } SEAM(pb + 1);
        if (IN(pb + 2)) { const Args a = load_args(); Frame F = make_frame(lds, a); F.kmean += (size_t)l * 128 * 384; MIXER_PHASE(F, a, l, l);
        } SEAM(pb + 2);
        if (IN(pb + 3)) {
            const Args a = load_args(); Frame F = make_frame(lds, a);
            pg8::Gemm g{F.y, F.bt2 + (size_t)l * DM * DM, DM, F.ssy}; pg8::Order2 S{F.G, F.bid};
            pg8::EpiResid E{F.xh, F.xh, F.ssx + (size_t)(l + 1) * MTOK};
            pg8::gemm_phase<pg8::EpiResid, pg8::Order2, true>(lds, g, S, E);
        } SEAM(pb + 3);
    }
    if (IN(7)) { const Args a = load_args(); Frame F = make_frame(lds, a);
        final_phase(F, a, a.out); }
#undef IN
#undef SEAM
}

#ifndef MK_PER_PHASE
#define MK_PER_PHASE 0
#endif
extern "C" void kernel_launch(void* const* d_in, const int* in_sizes, int n_in, void* d_out, int out_size, void* d_ws, size_t ws_size, hipStream_t stream) {
    static int grid = 0;
    if (grid == 0) {
        if (n_in != 14 || in_sizes[0] != MTOK * DM || out_size != MTOK * DM || ws_size < WS_END) { fprintf(stderr, "kernel_launch: unexpected shapes (n_in %d, in0 %d, out %d, ws %zu)\n", n_in, n_in > 0 ? in_sizes[0] : -1, out_size, ws_size); grid = -1; return; }
        int dev = 0, cus = 0, per_cu = 0;
        if (hipGetDevice(&dev) != hipSuccess || hipDeviceGetAttribute(&cus, hipDeviceAttributeMultiprocessorCount, dev) != hipSuccess) { grid = -1; return; }
        if (hipFuncSetAttribute((const void*)fwd_kernel, hipFuncAttributeMaxDynamicSharedMemorySize, LDS_BYTES) != hipSuccess) { fprintf(stderr, "kernel_launch: hipFuncSetAttribute failed\n"); grid = -1; return; }
        if (hipOccupancyMaxActiveBlocksPerMultiprocessor(&per_cu, (const void*)fwd_kernel, NTHR, LDS_BYTES) != hipSuccess || per_cu < 1) { fprintf(stderr, "kernel_launch: occupancy query says %d\n", per_cu); }
        (void)hipGetLastError();
        grid = cus;
    }
    if (grid < 0) return;
    (void)hipMemsetAsync((char*)d_ws + WS_CTL, 0, CTL_ZERO_BYTES, stream);
    Args a{};
    a.x = (const float*)d_in[0]; a.mem = (const float*)d_in[1]; a.norm_g = (const float*)d_in[2]; a.w_in = (const float*)d_in[3]; a.ln_g = (const float*)d_in[4]; a.ln_b = (const float*)d_in[5];
    a.sp_w = (const float*)d_in[6]; a.sp_b = (const float*)d_in[7]; a.rel_bias = (const float*)d_in[8]; a.mem_norm_g = (const float*)d_in[9]; a.w_kv = (const float*)d_in[10];
    a.br_g = (const float*)d_in[11]; a.w_out = (const float*)d_in[12]; a.fin_g = (const float*)d_in[13];
    a.out = (float*)d_out; a.ws = (unsigned char*)d_ws;
#if MK_PER_PHASE
    for (int p = 0; p < N_PHASES; ++p) { a.ph_lo = p; a.ph_hi = p + 1; hipLaunchKernelGGL(fwd_kernel, dim3(grid), dim3(NTHR), LDS_BYTES, stream, a); }
#else
    a.ph_lo = 0; a.ph_hi = N_PHASES; hipLaunchKernelGGL(fwd_kernel, dim3(grid), dim3(NTHR), LDS_BYTES, stream, a);
#endif
}
```

```cpp
#include <hip/hip_runtime.h>
#include <cstdio>
#include <cstdint>

#define LAS __attribute__((address_space(3)))
#define GAS __attribute__((address_space(1)))
typedef _Float16 half_t;
typedef _Float16 h8 __attribute__((ext_vector_type(8)));
typedef _Float16 h4 __attribute__((ext_vector_type(4)));
typedef _Float16 h2 __attribute__((ext_vector_type(2)));
typedef float f32x2 __attribute__((ext_vector_type(2)));
typedef float f32x4 __attribute__((ext_vector_type(4)));
typedef float f32x16 __attribute__((ext_vector_type(16)));
typedef unsigned u32x2 __attribute__((ext_vector_type(2)));
typedef unsigned u32x4 __attribute__((ext_vector_type(4)));

constexpr int NB = 16, SEQ = 2048, DM = 1024, MTOK = NB * SEQ, MEML = 256, MMEM = NB * MEML;
constexpr int DIN = 3200, NP1 = 3328, NKV = 512, NB1 = NP1 + NKV;
constexpr int C_U = 0, C_V = 384, C_QB = 768, C_KB = 1152, C_VB = 1536, C_QM = 1920, C_Z = 2176;
constexpr int PP = DIN;
constexpr float EPS = 1e-6f;
constexpr int NWAVES = 8, NTHR = 512;

constexpr size_t MiB = 1u << 20;
constexpr size_t WS_CTL = 0, CTL_ZERO_BYTES = 256 * 1024;
constexpr size_t WS_SSX = 1 * MiB;
constexpr size_t WS_SSY = 2 * MiB;
constexpr size_t WS_KMEAN = 4 * MiB;
constexpr size_t WS_LUT = 4 * MiB + 512 * 1024;
constexpr size_t WS_WSP = 5 * MiB;
constexpr size_t WS_BT2 = 6 * MiB;
constexpr size_t WS_BT1 = 10 * MiB;
constexpr size_t WS_MKV = 26 * MiB;
constexpr size_t WS_XH = 34 * MiB;
constexpr size_t WS_Y = 106 * MiB;
constexpr size_t WS_PROJ = 170 * MiB;
constexpr size_t WS_END = 370 * MiB;
constexpr int CW_TMO = 0, CW_BAR = 4096, CW_QUEUE = 8192, CW_PANEL = 12288;

constexpr int RING_BYTES = 131072;
constexpr int AT_STG_ROW = 68;
constexpr int GM_VNT = 0, GM_VNT_ROW = 136, GM_VNT_BYTES = 64 * GM_VNT_ROW * 2;
constexpr int GM_STAGE = 36864;
constexpr int MISC_OFF = 155648;
constexpr int LDS_BYTES = MISC_OFF + 256;
static_assert(RING_BYTES + 2 * 768 * 4 <= MISC_OFF, "LDS map");

__device__ __forceinline__ unsigned pkh(float lo, float hi) { f32x2 v = {lo, hi}; h2 h = __builtin_convertvector(v, h2); return __builtin_bit_cast(unsigned, h); }
__device__ __forceinline__ float gelu_t(float x) { const float t = x * (1.0f + 0.044715f * x * x) * (2.0f * 0.7978845608028654f * 1.4426950408889634f); return x * __builtin_amdgcn_rcpf(1.0f + __builtin_amdgcn_exp2f(-t)); }
__device__ __forceinline__ float silu_f(float x) { return x * __builtin_amdgcn_rcpf(1.0f + __builtin_amdgcn_exp2f(-x * 1.4426950408889634f)); }
__device__ __forceinline__ f32x2 silu_pk(f32x2 v) { const f32x2 w = v * (-1.4426950408889634f); f32x2 e; e.x = __builtin_amdgcn_exp2f(w.x); e.y = __builtin_amdgcn_exp2f(w.y);
    const f32x2 d = e + 1.0f; f32x2 r; r.x = __builtin_amdgcn_rcpf(d.x); r.y = __builtin_amdgcn_rcpf(d.y); return v * r; }
__device__ __forceinline__ f32x2 gelu_pk(f32x2 v) { constexpr float k1 = 2.0f * 0.7978845608028654f * 1.4426950408889634f, k2 = 0.044715f;
    const f32x2 t = v * v, u = t * (-k1 * k2) + (-k1), w = v * u; f32x2 e; e.x = __builtin_amdgcn_exp2f(w.x); e.y = __builtin_amdgcn_exp2f(w.y);
    const f32x2 d = e + 1.0f; f32x2 r; r.x = __builtin_amdgcn_rcpf(d.x); r.y = __builtin_amdgcn_rcpf(d.y); return v * r; }
__device__ __forceinline__ float wave_sum(float v) {
#pragma unroll
    for (int o = 1; o < 64; o <<= 1) v += __shfl_xor(v, o);
    return v;
}
__device__ __forceinline__ int t5_bucket(int d) {
    if (d < 16) return d;
    return 16 + (d >= 19) + (d >= 21) + (d >= 24) + (d >= 27) + (d >= 31) + (d >= 35) + (d >= 40) + (d >= 46) + (d >= 52) + (d >= 59) + (d >= 67) + (d >= 77) + (d >= 87) + (d >= 99) + (d >= 113);
}

namespace pg8 {
constexpr unsigned XB_SPIN_CAP_ = 1u << 18;
constexpr int BM = 256, BK = 64, HALF = 128, HTB = HALF * BK * 2, STAGE_BYTES = 8 * HTB;
__host__ __device__ __forceinline__ int lds_byte(int r, int c) { const int st = (r >> 4) * 2 + (c >> 5), rr = r & 15, cc = c & 31, ob = rr * 64 + cc * 2; return st * 1024 + (ob ^ (((ob >> 9) & 1) << 5)); }
__host__ __device__ __forceinline__ void stage_rc(int b, int& R, int& C) { const int st = b / 1024, sb = b % 1024, swz = sb ^ (((sb >> 9) & 1) << 5); R = (st >> 1) * 16 + swz / 64; C = (st & 1) * 32 + (swz % 64) / 2; }
__host__ __device__ __forceinline__ int perm32(int rho) { const int n = rho >> 4, i = rho & 15; return 8 * (i >> 2) + 4 * n + (i & 3); }
struct Unit { int pm, pn; };
struct Gemm { const half_t* A; const half_t* Bt; int K; const float* ssy; };

template <class Epi, class Sched, bool KSCALE>
__device__ __forceinline__ void gemm_phase(LAS unsigned char* lds, const Gemm g, const Sched& S, const Epi& E) {
    int tid_ = threadIdx.x; asm volatile("" : "+v"(tid_));
    const int tid = tid_, wid = __builtin_amdgcn_readfirstlane(tid >> 6), lane = tid & 63, wr = wid >> 2, wc = wid & 3, fr = lane & 15, fq = lane >> 4;
    const int K = g.K, nt = K / BK;
    unsigned voffA[2], voffB[2];
#pragma unroll
    for (int i = 0; i < 2; ++i) { int R, C; stage_rc(tid * 16 + i * 8192, R, C); const int Rb = (R & ~31) + perm32(R & 31);
        voffA[i] = (unsigned)(R * K + C) * 2u; voffB[i] = (unsigned)(Rb * K + C) * 2u; }
    const size_t kstep = (size_t)(BK * 2);
    const size_t hstep = (size_t)HALF * K * 2;
    const size_t tstep = 2 * hstep;
    const unsigned ldsw = (unsigned)wid * 1024u;
    const int aoff = lds_byte(wr * 64 + fr, fq * 8), boff = lds_byte(wc * 32 + fr, fq * 8);
#define PG8_SA(b, h) (((b) * 2 + (h)) * HTB)
#define PG8_SB(b, h) ((4 + (b) * 2 + (h)) * HTB)
#define PG8_STAGE(bufoff, gbase, voff) do { _Pragma("unroll") for (int _i = 0; _i < 2; ++_i) \
        __builtin_amdgcn_global_load_lds((const unsigned*)((const char*)(gbase) + (voff)[_i]), (LAS unsigned*)(lds + (bufoff) + ldsw + _i * 8192), 16, 0, 0); } while (0)
#define PG8_LDA(dst, b, h) do { _Pragma("unroll") for (int m = 0; m < 4; ++m) _Pragma("unroll") for (int k = 0; k < 2; ++k) dst[m][k] = *(const LAS h8*)(lds + PG8_SA(b, h) + aoff + m * 2048 + k * 1024); } while (0)
#define PG8_LDB(dst, b, h) do { _Pragma("unroll") for (int n = 0; n < 2; ++n) _Pragma("unroll") for (int k = 0; k < 2; ++k) dst[n][k] = *(const LAS h8*)(lds + PG8_SB(b, h) + boff + n * 2048 + k * 1024); } while (0)
#define PG8_MMA(ai, bj, At, Bt) do { __builtin_amdgcn_s_setprio(1); _Pragma("unroll") for (int m = 0; m < 4; ++m) _Pragma("unroll") for (int n = 0; n < 2; ++n) _Pragma("unroll") for (int k = 0; k < 2; ++k) \
        acc[ai][bj][m][n] = __builtin_amdgcn_mfma_f32_16x16x32_f16(Bt[n][k], At[m][k], acc[ai][bj][m][n], 0, 0, 0); __builtin_amdgcn_s_setprio(0); } while (0)
#define PG8_WAIT_V(n) asm volatile("s_waitcnt vmcnt(" #n ")" ::: "memory")
#define PG8_WAIT_L(n) asm volatile("s_waitcnt lgkmcnt(" #n ")" ::: "memory")
#define PG8_BAR __builtin_amdgcn_s_barrier()
#define PG8_SCHED __builtin_amdgcn_sched_barrier(0)
    Unit cur, nxt; int ui = 0;
    if (!S.next(0, cur)) return;
    f32x4 acc[2][2][4][2];
#pragma unroll
    for (int a = 0; a < 2; ++a)
#pragma unroll
        for (int b = 0; b < 2; ++b)
#pragma unroll
            for (int m = 0; m < 4; ++m)
#pragma unroll
                for (int n = 0; n < 2; ++n) acc[a][b][m][n] = (f32x4){0.f, 0.f, 0.f, 0.f};
    h8 At[4][2], B0[2][2], B1[2][2];
    const char* cA = (const char*)g.A + (size_t)cur.pm * tstep; const char* cB = (const char*)g.Bt + (size_t)cur.pn * tstep;
    PG8_STAGE(PG8_SB(0, 0), cB, voffB); PG8_STAGE(PG8_SB(0, 1), cB + hstep, voffB); PG8_STAGE(PG8_SA(0, 0), cA, voffA); PG8_STAGE(PG8_SA(0, 1), cA + hstep, voffA);
    if (wr == 1) PG8_BAR;
    PG8_WAIT_V(2); PG8_BAR;
    PG8_STAGE(PG8_SB(1, 0), cB + kstep, voffB); PG8_STAGE(PG8_SA(1, 0), cA + kstep, voffA); PG8_STAGE(PG8_SB(1, 1), cB + hstep + kstep, voffB);
    PG8_WAIT_V(6); PG8_BAR;
    LAS float* ktab = (LAS float*)(lds + RING_BYTES);
    for (;;) {
        const bool has_next = S.next(ui + 1, nxt);
        if constexpr (KSCALE) {
            if (tid < 256) { const f32x4* sp = (const f32x4*)(g.ssy + (size_t)(cur.pm * BM + tid) * 16); const f32x4 s0 = sp[0], s1 = sp[1], s2 = sp[2], s3 = sp[3];
                const float sa = ((s0[0] + s0[1]) + (s0[2] + s0[3])) + (s1[0] + s1[1]), sb = ((s1[2] + s1[3]) + (s2[0] + s2[1])) + (s2[2] + s2[3]), sm = (s3[0] + s3[1]) + (s3[2] + s3[3]);
                const float va = sa * (1.0f / 384.0f) + EPS, vb = sb * (1.0f / 384.0f) + EPS, vm = sm * (1.0f / 256.0f) + EPS;
                LAS float* T = ktab + (ui & 1) * 768;
                T[tid] = sqrtf(vb / va); T[256 + tid] = sqrtf(vm / vb); T[512 + tid] = __builtin_amdgcn_rsqf(vm); }
        }
        const char* nA = has_next ? (const char*)g.A + (size_t)nxt.pm * tstep : cA; const char* nB = has_next ? (const char*)g.Bt + (size_t)nxt.pn * tstep : cB;
        for (int t = 0; t < nt; t += 2) {
            const bool last = (t == nt - 2);
            const char* a1 = cA + (size_t)(t + 1) * kstep;
            const char* a2 = last ? nA : cA + (size_t)(t + 2) * kstep; const char* b2 = last ? nB : cB + (size_t)(t + 2) * kstep;
            const char* a3 = a2 + kstep; const char* b3 = b2 + kstep;
            if constexpr (KSCALE) {
                if (t == 6 || t == 12) { const LAS float* T = ktab + (ui & 1) * 768 + (t == 12 ? 256 : 0);
#pragma unroll
                    for (int ai = 0; ai < 2; ++ai)
#pragma unroll
                        for (int m = 0; m < 4; ++m) { const float f = T[ai * HALF + wr * 64 + m * 16 + fr];
#pragma unroll
                            for (int bj = 0; bj < 2; ++bj)
#pragma unroll
                                for (int n = 0; n < 2; ++n) acc[ai][bj][m][n] *= f; } }
            }
            PG8_LDB(B0, 0, 0); PG8_LDB(B1, 0, 1); PG8_SCHED; PG8_LDA(At, 0, 0); PG8_STAGE(PG8_SA(1, 1), a1 + hstep, voffA);
            PG8_WAIT_V(8); PG8_WAIT_L(0); PG8_BAR; PG8_MMA(0, 0, At, B0); PG8_MMA(0, 1, At, B1); PG8_BAR; PG8_SCHED;
            PG8_LDA(At, 0, 1); PG8_STAGE(PG8_SB(0, 0), b2, voffB); PG8_STAGE(PG8_SB(0, 1), b2 + hstep, voffB); PG8_STAGE(PG8_SA(0, 0), a2, voffA);
            PG8_WAIT_V(8); PG8_WAIT_L(0); PG8_BAR; PG8_MMA(1, 0, At, B0); PG8_MMA(1, 1, At, B1); PG8_BAR; PG8_SCHED;
            PG8_LDB(B0, 1, 0); PG8_LDB(B1, 1, 1); PG8_SCHED; PG8_LDA(At, 1, 0); PG8_STAGE(PG8_SA(0, 1), a2 + hstep, voffA);
            PG8_WAIT_V(8); PG8_WAIT_L(0); PG8_BAR; PG8_MMA(0, 0, At, B0); PG8_MMA(0, 1, At, B1); PG8_BAR; PG8_SCHED;
            PG8_LDA(At, 1, 1); PG8_STAGE(PG8_SB(1, 0), b3, voffB); PG8_STAGE(PG8_SB(1, 1), b3 + hstep, voffB); PG8_STAGE(PG8_SA(1, 0), a3, voffA);
            PG8_WAIT_V(8); PG8_WAIT_L(0); PG8_BAR; PG8_MMA(1, 0, At, B0); PG8_MMA(1, 1, At, B1); PG8_BAR; PG8_SCHED;
        }
        if (wr == 0) PG8_BAR;
        E(acc, cur, wr, wc, fr, fq, ktab + (ui & 1) * 768 + 512);
        if (!has_next) break;
#pragma unroll
        for (int a = 0; a < 2; ++a)
#pragma unroll
            for (int b = 0; b < 2; ++b)
#pragma unroll
                for (int m = 0; m < 4; ++m)
#pragma unroll
                    for (int n = 0; n < 2; ++n) acc[a][b][m][n] = (f32x4){0.f, 0.f, 0.f, 0.f};
        cur = nxt; cA = nA; cB = nB; ++ui;
        if (wr == 1) PG8_BAR;
    }
    PG8_WAIT_V(0);
    PG8_BAR;
#undef PG8_SA
#undef PG8_SB
#undef PG8_STAGE
#undef PG8_LDA
#undef PG8_LDB
#undef PG8_MMA
#undef PG8_WAIT_V
#undef PG8_WAIT_L
#undef PG8_BAR
#undef PG8_SCHED
}

struct Order1 {
    int G, c;
    __device__ __forceinline__ bool next(int i, Unit& u) const {
        const int L = i * G + c, x = L % 8, off = L / 8;
        if (off < 208) { const int w = x * 208 + off; const int nig = 8 * 13, gid = w / nig, rem = w % nig; u.pm = gid * 8 + (rem % 8); u.pn = rem / 8; return true; }
        if (off < 212) { const int k = off - 208; u.pm = 128 + 2 * x + (k >> 1); u.pn = 13 + (k & 1); return true; }
        return false;
    }
};
struct Order2 {
    int G, c;
    __device__ __forceinline__ bool next(int i, Unit& u) const {
        const int L = i * G + c; constexpr int NW = 128 * 4;
        if (L >= NW) return false;
        const int q = NW / 8, xcd = L % 8, off = L / 8, w = xcd * q + off; const int nig = 8 * 4, gid = w / nig, rem = w % nig; u.pm = gid * 8 + (rem % 8); u.pn = rem / 8; return true;
    }
};

struct EpiProj {
    half_t* proj; half_t* mkv; const float* ssx; float* kmsum;
    __device__ __forceinline__ void operator()(const f32x4 (&acc)[2][2][4][2], const Unit& u, int wr, int wc, int fr, int fq, const LAS float*) const {
        if (u.pm >= 128) {
            const int row0 = (u.pm - 128) * BM + wr * 64 + fr, col0 = (u.pn - 13) * BM + wc * 32 + 8 * fq;
#pragma unroll
            for (int ai = 0; ai < 2; ++ai)
#pragma unroll
                for (int m = 0; m < 4; ++m) { half_t* rowp = mkv + (size_t)(row0 + ai * HALF + m * 16) * NKV + col0;
#pragma unroll
                    for (int bj = 0; bj < 2; ++bj) { const f32x4 v0 = acc[ai][bj][m][0], v1 = acc[ai][bj][m][1]; u32x4 w; w.x = pkh(v0[0], v0[1]); w.y = pkh(v0[2], v0[3]); w.z = pkh(v1[0], v1[1]); w.w = pkh(v1[2], v1[3]);
                        *(u32x4*)(rowp + bj * HALF) = w; } }
            return;
        }
        const int row0 = u.pm * BM + wr * 64 + fr;
        float rs[2][4];
#pragma unroll
        for (int ai = 0; ai < 2; ++ai)
#pragma unroll
            for (int m = 0; m < 4; ++m) rs[ai][m] = ssx[row0 + ai * HALF + m * 16];
#pragma unroll
        for (int ai = 0; ai < 2; ++ai)
#pragma unroll
            for (int m = 0; m < 4; ++m) rs[ai][m] = __builtin_amdgcn_rsqf(rs[ai][m] * (1.0f / DM) + EPS);
#pragma unroll
        for (int bj = 0; bj < 2; ++bj) {
            const int c128 = u.pn * 2 + bj;
            if (c128 >= 25) continue;
            const int col0 = c128 * HALF + wc * 32 + 8 * fq;
            if (c128 >= 9 && c128 < 12) {
                f32x4 c0 = (f32x4){0.f, 0.f, 0.f, 0.f}, c1 = c0;
#pragma unroll
                for (int ai = 0; ai < 2; ++ai)
#pragma unroll
                    for (int m = 0; m < 4; ++m) { c0 += acc[ai][bj][m][0] * rs[ai][m]; c1 += acc[ai][bj][m][1] * rs[ai][m]; }
#pragma unroll
                for (int e = 0; e < 4; ++e) {
#pragma unroll
                    for (int o = 1; o < 16; o <<= 1) { c0[e] += __shfl_xor(c0[e], o); c1[e] += __shfl_xor(c1[e], o); } }
                if (fr == 0) { float* kp = kmsum + (size_t)u.pm * 384 + (col0 - C_KB);
#pragma unroll
                    for (int e = 0; e < 4; ++e) { atomicAdd(kp + e, c0[e]); atomicAdd(kp + 4 + e, c1[e]); } }
            }
#pragma unroll
            for (int ai = 0; ai < 2; ++ai)
#pragma unroll
                for (int m = 0; m < 4; ++m) { const int row = row0 + ai * HALF + m * 16;
                    f32x4 v0 = acc[ai][bj][m][0] * rs[ai][m], v1 = acc[ai][bj][m][1] * rs[ai][m];
                    if (c128 >= 17) {
#pragma unroll
                        for (int e = 0; e < 4; e += 2) { const f32x2 a = silu_pk((f32x2){v0[e], v0[e + 1]}), b = silu_pk((f32x2){v1[e], v1[e + 1]}); v0[e] = a.x; v0[e + 1] = a.y; v1[e] = b.x; v1[e + 1] = b.y; } }
                    else if (c128 < 6) {
#pragma unroll
                        for (int e = 0; e < 4; e += 2) { const f32x2 a = gelu_pk((f32x2){v0[e], v0[e + 1]}), b = gelu_pk((f32x2){v1[e], v1[e + 1]}); v0[e] = a.x; v0[e + 1] = a.y; v1[e] = b.x; v1[e + 1] = b.y; } }
                    u32x4 w; w.x = pkh(v0[0], v0[1]); w.y = pkh(v0[2], v0[3]); w.z = pkh(v1[0], v1[1]); w.w = pkh(v1[2], v1[3]);
                    *(u32x4*)(proj + (size_t)row * PP + col0) = w; }
        }
    }
};
struct EpiResid {
    const half_t* resid16; half_t* xh; float* ssn;
    __device__ __forceinline__ void operator()(const f32x4 (&acc)[2][2][4][2], const Unit& u, int wr, int wc, int fr, int fq, const LAS float* T3) const {
        const int row0 = u.pm * BM + wr * 64 + fr, col0 = u.pn * BM + wc * 32 + 8 * fq;
#pragma unroll
        for (int ai = 0; ai < 2; ++ai) {
            h8 rh[4][2]; float f3[4];
#pragma unroll
            for (int m = 0; m < 4; ++m) { const size_t off = (size_t)(row0 + ai * HALF + m * 16) * DM + col0;
                rh[m][0] = *(const h8*)(resid16 + off); rh[m][1] = *(const h8*)(resid16 + off + HALF); f3[m] = T3[ai * HALF + wr * 64 + m * 16 + fr]; }
#pragma unroll
            for (int m = 0; m < 4; ++m) { const int row = row0 + ai * HALF + m * 16; const size_t off = (size_t)row * DM + col0; float s = 0.f; f32x2 s2 = {0.f, 0.f};
#pragma unroll
                for (int bj = 0; bj < 2; ++bj) { const h8 r = rh[m][bj];
                    const f32x4 v0 = acc[ai][bj][m][0] * f3[m] + (f32x4){(float)r[0], (float)r[1], (float)r[2], (float)r[3]}, v1 = acc[ai][bj][m][1] * f3[m] + (f32x4){(float)r[4], (float)r[5], (float)r[6], (float)r[7]};
                    u32x4 w; w.x = pkh(v0[0], v0[1]); w.y = pkh(v0[2], v0[3]); w.z = pkh(v1[0], v1[1]); w.w = pkh(v1[2], v1[3]);
                    *(u32x4*)(xh + off + bj * HALF) = w;
                    s2 = (f32x2){v0[0], v0[1]} * (f32x2){v0[0], v0[1]} + s2; s2 = (f32x2){v0[2], v0[3]} * (f32x2){v0[2], v0[3]} + s2;
                    s2 = (f32x2){v1[0], v1[1]} * (f32x2){v1[0], v1[1]} + s2; s2 = (f32x2){v1[2], v1[3]} * (f32x2){v1[2], v1[3]} + s2; }
                s = s2.x + s2.y;
                s += __shfl_xor(s, 16); s += __shfl_xor(s, 32);
                if (fq == 0) atomicAdd(ssn + row, s); }
            asm volatile("" ::: "memory");
        }
    }
};
struct EpiFinal {
    const half_t* resid16; float* out; float* ssn; const float* fin_g; unsigned* pcnt; unsigned* tmo;
    __device__ __forceinline__ void operator()(f32x4 (&acc)[2][2][4][2], const Unit& u, int wr, int wc, int fr, int fq, const LAS float* T3) const {
        const int row0 = u.pm * BM + wr * 64 + fr, col0 = u.pn * BM + wc * 32 + 8 * fq;
#pragma unroll
        for (int ai = 0; ai < 2; ++ai) {
            h8 rh[4][2]; float f3[4];
#pragma unroll
            for (int m = 0; m < 4; ++m) { const size_t off = (size_t)(row0 + ai * HALF + m * 16) * DM + col0;
                rh[m][0] = *(const h8*)(resid16 + off); rh[m][1] = *(const h8*)(resid16 + off + HALF); f3[m] = T3[ai * HALF + wr * 64 + m * 16 + fr]; }
#pragma unroll
            for (int m = 0; m < 4; ++m) { const int row = row0 + ai * HALF + m * 16; float s = 0.f; f32x2 s2 = {0.f, 0.f};
#pragma unroll
                for (int bj = 0; bj < 2; ++bj) { const h8 r = rh[m][bj];
                    const f32x4 v0 = acc[ai][bj][m][0] * f3[m] + (f32x4){(float)r[0], (float)r[1], (float)r[2], (float)r[3]}, v1 = acc[ai][bj][m][1] * f3[m] + (f32x4){(float)r[4], (float)r[5], (float)r[6], (float)r[7]};
                    acc[ai][bj][m][0] = v0; acc[ai][bj][m][1] = v1;
                    s2 = (f32x2){v0[0], v0[1]} * (f32x2){v0[0], v0[1]} + s2; s2 = (f32x2){v0[2], v0[3]} * (f32x2){v0[2], v0[3]} + s2;
                    s2 = (f32x2){v1[0], v1[1]} * (f32x2){v1[0], v1[1]} + s2; s2 = (f32x2){v1[2], v1[3]} * (f32x2){v1[2], v1[3]} + s2; }
                s = s2.x + s2.y;
                s += __shfl_xor(s, 16); s += __shfl_xor(s, 32);
                if (fq == 0) atomicAdd(ssn + row, s); }
        }
        asm volatile("s_waitcnt vmcnt(0)" ::: "memory");
        unsigned* cnt = pcnt + 64 * u.pm;
        if ((threadIdx.x & 63) == 0) (void)__hip_atomic_fetch_add(cnt, 1u, __ATOMIC_RELAXED, __HIP_MEMORY_SCOPE_AGENT);
        { unsigned sp = 0u;
          while ((unsigned)__builtin_amdgcn_readfirstlane((int)__hip_atomic_load(cnt, __ATOMIC_RELAXED, __HIP_MEMORY_SCOPE_AGENT)) < 32u) {
              __builtin_amdgcn_s_sleep(2);
              if ((++sp & 255u) == 0u) { if (__hip_atomic_load(tmo, __ATOMIC_RELAXED, __HIP_MEMORY_SCOPE_AGENT)) break; if (sp > XB_SPIN_CAP_) { atomicAdd(tmo, 1u); break; } } } }
        f32x4 g[2][2];
#pragma unroll
        for (int bj = 0; bj < 2; ++bj) { g[bj][0] = *(const f32x4*)(fin_g + col0 + bj * HALF); g[bj][1] = *(const f32x4*)(fin_g + col0 + bj * HALF + 4); }
#pragma unroll
        for (int ai = 0; ai < 2; ++ai) {
            float rs[4];
#pragma unroll
            for (int m = 0; m < 4; ++m) rs[m] = __hip_atomic_load(ssn + row0 + ai * HALF + m * 16, __ATOMIC_RELAXED, __HIP_MEMORY_SCOPE_AGENT);
#pragma unroll
            for (int m = 0; m < 4; ++m) { const float r = __builtin_amdgcn_rsqf(rs[m] * (1.0f / DM) + EPS); float* op = out + (size_t)(row0 + ai * HALF + m * 16) * DM + col0;
#pragma unroll
                for (int bj = 0; bj < 2; ++bj) { __builtin_nontemporal_store(acc[ai][bj][m][0] * r * g[bj][0], (f32x4*)(op + bj * HALF)); __builtin_nontemporal_store(acc[ai][bj][m][1] * r * g[bj][1], (f32x4*)(op + bj * HALF + 4)); } }
        }
    }
};
}

#define XB_TMO      128
#define XB_XCNT(j)  (256  + 64 * (j))
#define XB_XSUB(j)  (1280 + 64 * (j))
#define XB_XGEN(j)  (2304 + 64 * (j))
#define XB_TOP      3328
#define XB_TOPGEN   3392
#define XCD_BAR_WORDS 3456
#define XB_SPIN_CAP (1u << 18)
__device__ __forceinline__ unsigned xb_ld(unsigned* p)              { return __hip_atomic_load(p, __ATOMIC_RELAXED, __HIP_MEMORY_SCOPE_AGENT); }
__device__ __forceinline__ unsigned xb_add(unsigned* p, unsigned v) { return __hip_atomic_fetch_add(p, v, __ATOMIC_RELAXED, __HIP_MEMORY_SCOPE_AGENT); }
__device__ __forceinline__ unsigned xb_xcc_id() { return (unsigned)__builtin_amdgcn_s_getreg((3 << 11) | 20) & 0xFu; }
#define XB_SPIN(cond, bar) do { unsigned _sp = 0; while (cond) { __builtin_amdgcn_s_sleep(1); \
    if ((++_sp & 255u) == 0u) { if (xb_ld(&(bar)[XB_TMO])) break; if (_sp > XB_SPIN_CAP) { atomicAdd(&(bar)[XB_TMO], 1u); break; } } } } while (0)
struct XcdBarrier { unsigned* bar; unsigned x; volatile LAS unsigned* st; };
__device__ __forceinline__ XcdBarrier xcd_barrier_post(unsigned* bar, volatile LAS unsigned* st) {
    XcdBarrier b; b.bar = bar; b.x = xb_xcc_id(); b.st = st;
    if (threadIdx.x == 0) (void)xb_add(&bar[XB_XCNT(b.x)], 1u);
    return b;
}
__device__ __forceinline__ void xcd_barrier_complete(unsigned* bar, unsigned x, unsigned& nloc, unsigned& nx) {
    const unsigned G = gridDim.x * gridDim.y * gridDim.z;
    unsigned sum, cnt, mine, sp = 0u;
    for (;;) {
        sum = 0u; cnt = 0u; mine = 0u;
#pragma unroll
        for (unsigned j = 0; j < 16; ++j) { const unsigned c = xb_ld(&bar[XB_XCNT(j)]); sum += c; cnt += (c > 0u) ? 1u : 0u; mine = (j == x) ? c : mine; }
        if (sum == G) break;
        __builtin_amdgcn_s_sleep(1);
        if ((++sp & 255u) == 0u) { if (xb_ld(&bar[XB_TMO])) break; if (sp > XB_SPIN_CAP) { atomicAdd(&bar[XB_TMO], 1u); break; } }
    }
    nloc = mine > 0u ? mine : 1u; nx = cnt > 0u ? cnt : 1u;
}
__device__ __forceinline__ void xcd_barrier(const XcdBarrier& b) {
    asm volatile("s_waitcnt vmcnt(0)" ::: "memory");
    __syncthreads();
    if (threadIdx.x == 0) {
        unsigned* bar = b.bar;
        __builtin_amdgcn_s_waitcnt(0);
        unsigned nloc = b.st[0], nx = b.st[1];
        if (nloc == 0u) { xcd_barrier_complete(bar, b.x, nloc, nx); b.st[0] = nloc; b.st[1] = nx; }
        const unsigned old = xb_add(&bar[XB_XSUB(b.x)], 1u);
        const unsigned gen = old / nloc;
        if (old + 1u == (gen + 1u) * nloc) {
            __builtin_amdgcn_fence(__ATOMIC_RELEASE, "agent");
            asm volatile("s_waitcnt vmcnt(0)" ::: "memory");
            const unsigned og = xb_add(&bar[XB_TOP], 1u);
            const unsigned tg = og / nx;
            if (og + 1u == (tg + 1u) * nx) xb_add(&bar[XB_TOPGEN], 1u);
            else XB_SPIN(xb_ld(&bar[XB_TOPGEN]) == tg, bar);
            __builtin_amdgcn_fence(__ATOMIC_ACQUIRE, "agent");
            xb_add(&bar[XB_XGEN(b.x)], 1u);
            asm volatile("s_waitcnt vmcnt(0)" ::: "memory");
        } else {
            XB_SPIN(xb_ld(&bar[XB_XGEN(b.x)]) == gen, bar);
            __builtin_amdgcn_fence(__ATOMIC_ACQUIRE, "agent");
            asm volatile("s_waitcnt vmcnt(0)" ::: "memory");
        }
    }
    __syncthreads();
}

constexpr int GB_BASE = 32768;
#define GB_XCNT(g, x) (GB_BASE + ((g) * 16 + (x)) * 64)
#define GB_XSUB(g, x) (GB_BASE + 8192 + ((g) * 16 + (x)) * 64)
#define GB_XGEN(g, x) (GB_BASE + 16384 + ((g) * 16 + (x)) * 64)
#define GB_TOP(g)     (GB_BASE + 24576 + (g) * 64)
#define GB_TOPGEN(g)  (GB_BASE + 25088 + (g) * 64)
constexpr int GB_END = GB_BASE + 25600;
static_assert((size_t)GB_END * 4 <= CTL_ZERO_BYTES, "control words inside the zeroed region");
struct GrpBarrier { unsigned* ctl; unsigned g, x, gsize; volatile LAS unsigned* st; };
__device__ __forceinline__ GrpBarrier grp_barrier_post(unsigned* ctl, volatile LAS unsigned* st) {
    GrpBarrier b; b.ctl = ctl; b.g = blockIdx.x & 7u; b.x = xb_xcc_id(); b.gsize = (gridDim.x + 7u - b.g) / 8u; b.st = st;
    if (threadIdx.x == 0) (void)xb_add(&ctl[GB_XCNT(b.g, b.x)], 1u);
    return b;
}
__device__ __forceinline__ void grp_barrier_complete(const GrpBarrier& b, unsigned& nloc, unsigned& nx) {
    unsigned* tmo = b.ctl + CW_BAR;
    unsigned sum, cnt, mine, sp = 0u;
    for (;;) {
        sum = 0u; cnt = 0u; mine = 0u;
#pragma unroll
        for (unsigned j = 0; j < 16; ++j) { const unsigned c = xb_ld(&b.ctl[GB_XCNT(b.g, j)]); sum += c; cnt += (c > 0u) ? 1u : 0u; mine = (j == b.x) ? c : mine; }
        if (sum == b.gsize) break;
        __builtin_amdgcn_s_sleep(1);
        if ((++sp & 255u) == 0u) { if (xb_ld(&tmo[XB_TMO])) break; if (sp > XB_SPIN_CAP) { atomicAdd(&tmo[XB_TMO], 1u); break; } }
    }
    nloc = mine > 0u ? mine : 1u; nx = cnt > 0u ? cnt : 1u;
}
__device__ __forceinline__ void grp_barrier(const GrpBarrier& b) {
    asm volatile("s_waitcnt vmcnt(0)" ::: "memory");
    __syncthreads();
    if (threadIdx.x == 0) {
        unsigned* ctl = b.ctl; unsigned* tmo = ctl + CW_BAR;
        __builtin_amdgcn_s_waitcnt(0);
        unsigned nloc = b.st[0], nx = b.st[1];
        if (nloc == 0u) { grp_barrier_complete(b, nloc, nx); b.st[0] = nloc; b.st[1] = nx; }
        const unsigned old = xb_add(&ctl[GB_XSUB(b.g, b.x)], 1u);
        const unsigned gen = old / nloc;
        if (old + 1u == (gen + 1u) * nloc) {
            __builtin_amdgcn_fence(__ATOMIC_RELEASE, "agent");
            asm volatile("s_waitcnt vmcnt(0)" ::: "memory");
            const unsigned og = xb_add(&ctl[GB_TOP(b.g)], 1u);
            const unsigned tg = og / nx;
            if (og + 1u == (tg + 1u) * nx) xb_add(&ctl[GB_TOPGEN(b.g)], 1u);
            else XB_SPIN(xb_ld(&ctl[GB_TOPGEN(b.g)]) == tg, tmo);
            __builtin_amdgcn_fence(__ATOMIC_ACQUIRE, "agent");
            xb_add(&ctl[GB_XGEN(b.g, b.x)], 1u);
            asm volatile("s_waitcnt vmcnt(0)" ::: "memory");
        } else {
            XB_SPIN(xb_ld(&ctl[GB_XGEN(b.g, b.x)]) == gen, tmo);
            __builtin_amdgcn_fence(__ATOMIC_ACQUIRE, "agent");
            asm volatile("s_waitcnt vmcnt(0)" ::: "memory");
        }
    }
    __syncthreads();
}

struct Args {
    const float* x; const float* mem; const float* norm_g; const float* w_in; const float* ln_g; const float* ln_b; const float* sp_w; const float* sp_b;
    const float* rel_bias; const float* mem_norm_g; const float* w_kv; const float* br_g; const float* w_out; const float* fin_g;
    float* out; unsigned char* ws; int ph_lo, ph_hi;
};
struct Frame {
    LAS unsigned char* lds; int tid, lane, wave, G, bid;
    unsigned* ctl; float* ssx; float* ssy; float* kmean; half_t* wsp; half_t* bt2; half_t* bt1; half_t* mkv; half_t* xh; half_t* y; half_t* proj;
};
typedef const Args __attribute__((address_space(4))) * KArgs;
__device__ __forceinline__ KArgs kargs() { unsigned long long v = (unsigned long long)__builtin_amdgcn_kernarg_segment_ptr(); asm volatile("" : "+s"(v)); return (KArgs)v; }
__device__ __forceinline__ Args load_args() {
    KArgs p = kargs(); Args a;
    a.x = p->x; a.mem = p->mem; a.norm_g = p->norm_g; a.w_in = p->w_in; a.ln_g = p->ln_g; a.ln_b = p->ln_b; a.sp_w = p->sp_w; a.sp_b = p->sp_b;
    a.rel_bias = p->rel_bias; a.mem_norm_g = p->mem_norm_g; a.w_kv = p->w_kv; a.br_g = p->br_g; a.w_out = p->w_out; a.fin_g = p->fin_g;
    a.out = p->out; a.ws = p->ws; a.ph_lo = p->ph_lo; a.ph_hi = p->ph_hi;
    return a;
}
__device__ __forceinline__ Frame make_frame(LAS unsigned char* lds, const Args& a) {
    Frame F; F.lds = lds;
    int t = threadIdx.x; asm volatile("" : "+v"(t));
    F.tid = t; F.lane = t & 63; F.wave = __builtin_amdgcn_readfirstlane(t >> 6); F.G = gridDim.x; F.bid = blockIdx.x;
    unsigned char* ws = a.ws;
    F.ctl = (unsigned*)(ws + WS_CTL); F.ssx = (float*)(ws + WS_SSX); F.ssy = (float*)(ws + WS_SSY); F.kmean = (float*)(ws + WS_KMEAN);
    F.wsp = (half_t*)(ws + WS_WSP); F.bt2 = (half_t*)(ws + WS_BT2); F.bt1 = (half_t*)(ws + WS_BT1); F.mkv = (half_t*)(ws + WS_MKV);
    F.xh = (half_t*)(ws + WS_XH); F.y = (half_t*)(ws + WS_Y); F.proj = (half_t*)(ws + WS_PROJ);
    return F;
}

__device__ __forceinline__ void p0_transpose_item(const float* W, int K, int N, half_t* WT, int row_off, const float* gk, bool qscale, LAS float* scr, int item, int lane) {
    const int nblk = N / 32, kb = item / nblk, nb = item % nblk, k0 = 64 * kb, n0 = 32 * nb;
#pragma unroll 8
    for (int i = 0; i < 32; ++i) { const int kk = 2 * i + (lane >> 5); scr[kk * 33 + (lane & 31)] = __builtin_nontemporal_load(W + (size_t)(k0 + kk) * N + n0 + (lane & 31)) * gk[k0 + kk]; }
    asm volatile("s_waitcnt lgkmcnt(0)" ::: "memory");
    const int c = lane & 7;
#pragma unroll
    for (int j = 0; j < 4; ++j) { const int n = (lane >> 3) + 8 * j; const LAS float* s = scr + (8 * c) * 33 + n;
        const int ng = n0 + n; const float sc = (qscale && ((ng >= C_QB && ng < C_KB) || (ng >= C_QM && ng < C_Z))) ? 0.125f * 1.4426950408889634f : 1.0f;
        u32x4 o; o.x = pkh(s[0 * 33] * sc, s[1 * 33] * sc); o.y = pkh(s[2 * 33] * sc, s[3 * 33] * sc); o.z = pkh(s[4 * 33] * sc, s[5 * 33] * sc); o.w = pkh(s[6 * 33] * sc, s[7 * 33] * sc);
        *(u32x4*)(WT + (size_t)(row_off + n0 + n) * K + k0 + 8 * c) = o; }
    asm volatile("s_waitcnt lgkmcnt(0)" ::: "memory");
}
__device__ __forceinline__ float row_to_half(const float* xrow, half_t* orow, bool normalise, int lane) {
    const f32x4* xr = (const f32x4*)xrow + lane;
    f32x4 v[4]; float s = 0.f;
#pragma unroll
    for (int j = 0; j < 4; ++j) { v[j] = xr[64 * j]; s += (v[j].x * v[j].x + v[j].y * v[j].y) + (v[j].z * v[j].z + v[j].w * v[j].w); }
    s = wave_sum(s);
    const float sc = normalise ? __builtin_amdgcn_rsqf(s * (1.0f / DM) + EPS) : 1.0f;
    u32x2* o8 = (u32x2*)orow + lane;
#pragma unroll
    for (int j = 0; j < 4; ++j) { u32x2 w; w.x = pkh(v[j].x * sc, v[j].y * sc); w.y = pkh(v[j].z * sc, v[j].w * sc); o8[64 * j] = w; }
    return s;
}
__device__ __forceinline__ void p0_weights(Frame& F, const Args& a) {
    LAS float* scr = (LAS float*)(F.lds + F.wave * 16384);
    const int gw = F.bid * NWAVES + F.wave, NGW = F.G * NWAVES;
    constexpr int I_IN = (DM / 64) * (DIN / 32), I_KV = (DM / 64) * (NKV / 32), I_OUT = (DM / 64) * (DM / 32);
    constexpr int PER_L = I_IN + I_KV + I_OUT;
    for (int it = gw; it < 2 * PER_L; it += NGW) {
        const int l = it / PER_L; int r = it % PER_L;
        if (r < I_IN) { p0_transpose_item(a.w_in + (size_t)l * DM * DIN, DM, DIN, F.bt1 + (size_t)l * NB1 * DM, 0, a.norm_g + l * DM, true, scr, r, F.lane); continue; } r -= I_IN;
        if (r < I_KV) { p0_transpose_item(a.w_kv + (size_t)l * DM * NKV, DM, NKV, F.bt1 + (size_t)l * NB1 * DM, NP1, a.mem_norm_g + l * DM, false, scr, r, F.lane); continue; } r -= I_KV;
        p0_transpose_item(a.w_out + (size_t)l * DM * DM, DM, DM, F.bt2 + (size_t)l * DM * DM, 0, a.br_g + l * DM, false, scr, r, F.lane);
    }
}
__device__ __forceinline__ void p0_rows(Frame& F, const Args& a) {
    const int gw = F.bid * NWAVES + F.wave, NGW = F.G * NWAVES;
    for (int m0 = gw * 4; m0 < MTOK + MMEM; m0 += NGW * 4) {
        const bool isx = m0 < MTOK; const float* src = isx ? a.x + (size_t)m0 * DM : a.mem + (size_t)(m0 - MTOK) * DM;
        f32x4 v[4][4];
#pragma unroll
        for (int i = 0; i < 4; ++i) { const f32x4* xr = (const f32x4*)(src + (size_t)i * DM) + 2 * F.lane;
#pragma unroll
            for (int j = 0; j < 2; ++j) { v[i][2 * j] = __builtin_nontemporal_load(xr + 128 * j); v[i][2 * j + 1] = __builtin_nontemporal_load(xr + 128 * j + 1); } }
#pragma unroll
        for (int i = 0; i < 4; ++i) { float s = 0.f;
#pragma unroll
            for (int j = 0; j < 4; ++j) s += (v[i][j].x * v[i][j].x + v[i][j].y * v[i][j].y) + (v[i][j].z * v[i][j].z + v[i][j].w * v[i][j].w);
            s = wave_sum(s);
            const float sc = isx ? 1.0f : __builtin_amdgcn_rsqf(s * (1.0f / DM) + EPS);
            u32x4* o16 = (u32x4*)(F.xh + (size_t)(m0 + i) * DM) + F.lane;
#pragma unroll
            for (int j = 0; j < 2; ++j) { u32x4 w; w.x = pkh(v[i][2 * j].x * sc, v[i][2 * j].y * sc); w.y = pkh(v[i][2 * j].z * sc, v[i][2 * j].w * sc);
                w.z = pkh(v[i][2 * j + 1].x * sc, v[i][2 * j + 1].y * sc); w.w = pkh(v[i][2 * j + 1].z * sc, v[i][2 * j + 1].w * sc); o16[64 * j] = w; }
            if (isx && F.lane == 0) F.ssx[m0 + i] = s; }
    }
}
__device__ __forceinline__ void p0_prologue(Frame& F, const Args& a) {
    if (F.wave & 1) { p0_rows(F, a); p0_weights(F, a); } else { p0_weights(F, a); p0_rows(F, a); }
    const int gt = F.bid * NTHR + F.tid, NGT = F.G * NTHR;
    for (int i = gt; i < 2 * 128 * DM / 8; i += NGT) { const int l = i / (128 * DM / 8), r = i % (128 * DM / 8); *(u32x4*)(F.bt1 + (size_t)l * NB1 * DM + (size_t)DIN * DM + (size_t)r * 8) = (u32x4){0u, 0u, 0u, 0u}; }
    for (int i = gt; i < 2 * 6 * 128 * 128; i += NGT) { const int s = i & 127, t = (i >> 7) & 127; F.wsp[i] = (half_t)(s <= t ? a.sp_w[i] : 0.0f); }
    for (int i = gt; i < 2 * MTOK; i += NGT) F.ssx[MTOK + i] = 0.f;
    for (int i = gt; i < 2 * 128 * 384; i += NGT) F.kmean[i] = 0.f;
    for (int i = gt; i < 6 * 768; i += NGT) { const int h = i / 768, d = 511 - (i % 768); ((float*)(a.ws + WS_LUT))[i] = d < 0 ? -INFINITY : a.rel_bias[t5_bucket(d > 127 ? 127 : d) * 6 + h] * 1.4426950408889634f; }
}

namespace fa {
typedef short s16x4 __attribute__((ext_vector_type(4)));
typedef short s16x8 __attribute__((ext_vector_type(8)));
typedef short v4i16_t __attribute__((ext_vector_type(4)));
typedef LAS const unsigned char* lds_cptr;
constexpr int NSLOT = 4, NSLOTV = 4, SLOTB = 8192, KVBLK = 64;
constexpr int LDS_K = 0, LDS_V = NSLOT * SLOTB, LDS_WS = (NSLOT + NSLOTV) * SLOTB, LDS_STG = LDS_WS + 2048, STG_ROW = 68, STG_W = 32 * STG_ROW * 4, LDS_LUT = LDS_STG + 8 * STG_W, LUT_N = 768, LDS_END = LDS_LUT + 6 * LUT_N * 4;
#define SBAR() __builtin_amdgcn_sched_barrier(0)
__device__ __forceinline__ int crow(int r, int hi) { return (r & 3) + 8 * (r >> 2) + 4 * hi; }
__device__ __forceinline__ void glds16(const void* gsrc, unsigned lds_dst) { unsigned keep;
    asm volatile("s_mov_b32 %0, m0\n\ts_mov_b32 m0, %2\n\ts_nop 0\n\tglobal_load_lds_dwordx4 %1, off\n\ts_mov_b32 m0, %0" : "=&s"(keep) : "v"(gsrc), "s"(lds_dst) : "memory"); }
__device__ __forceinline__ float max3f(float a, float b, float c) { float r; asm("v_max3_f32 %0, %1, %2, %3" : "=v"(r) : "v"(a), "v"(b), "v"(c)); return r; }
__device__ __forceinline__ float max2f(float a, float b) { float r; asm("v_max_f32_e32 %0, %1, %2" : "=v"(r) : "v"(a), "v"(b)); return r; }
__device__ __forceinline__ float fadd_s(float a, float b) { float r; asm("v_add_f32_e32 %0, %1, %2" : "=v"(r) : "v"(a), "v"(b)); return r; }
__device__ __forceinline__ float fsub_s(float a, float b) { float r; asm("v_sub_f32_e32 %0, %1, %2" : "=v"(r) : "v"(a), "v"(b)); return r; }
#define WAIT_BAR(N) asm volatile("s_waitcnt vmcnt(" #N ") lgkmcnt(0)\n\ts_barrier" ::: "memory")
__device__ __forceinline__ void qkt(f32x16& p0, f32x16& p1, lds_cptr Kslot, const h8* qr, const f32x16& negm, int r32, int hi) {
    lds_cptr kb = Kslot + hi * 1024 + r32 * 16;
#pragma unroll
    for (int d0 = 0; d0 < 4; ++d0) {
        const h8 b0 = *(const LAS h8*)(kb + d0 * 2048);
        const h8 b1 = *(const LAS h8*)(kb + d0 * 2048 + 512);
        if (d0 == 0) { p0 = __builtin_amdgcn_mfma_f32_32x32x16_f16(b0, qr[0], negm, 0, 0, 0); p1 = __builtin_amdgcn_mfma_f32_32x32x16_f16(b1, qr[0], negm, 0, 0, 0); }
        else { p0 = __builtin_amdgcn_mfma_f32_32x32x16_f16(b0, qr[d0], p0, 0, 0, 0); p1 = __builtin_amdgcn_mfma_f32_32x32x16_f16(b1, qr[d0], p1, 0, 0, 0); } }
}
__device__ __forceinline__ void kload8(h8* kf, lds_cptr kp) {
    kf[0] = *(const LAS h8*)(kp);        kf[1] = *(const LAS h8*)(kp + 512);
    kf[2] = *(const LAS h8*)(kp + 2048); kf[3] = *(const LAS h8*)(kp + 2560);
    kf[4] = *(const LAS h8*)(kp + 4096); kf[5] = *(const LAS h8*)(kp + 4608);
    kf[6] = *(const LAS h8*)(kp + 6144); kf[7] = *(const LAS h8*)(kp + 6656);
}
__device__ __forceinline__ void kload2(h8* kf, lds_cptr kp, int j) { kf[2 * j] = *(const LAS h8*)(kp + j * 2048); kf[2 * j + 1] = *(const LAS h8*)(kp + j * 2048 + 512); }
__device__ __forceinline__ s16x4 vtr(lds_cptr p) { return __builtin_bit_cast(s16x4, __builtin_amdgcn_ds_read_tr16_b64_v4i16((LAS v4i16_t*)p)); }
__device__ __forceinline__ float rowmax(const f32x16& p0, const f32x16& p1) {
    float a = max3f(p0[0], p0[1], p1[0]), b = max3f(p0[2], p0[3], p1[1]); a = max3f(a, p1[2], p1[3]);
#pragma unroll
    for (int r = 4; r < 16; r += 4) { a = max3f(a, p0[r], p0[r + 1]); b = max3f(b, p0[r + 2], p0[r + 3]); a = max3f(a, p1[r], p1[r + 1]); b = max3f(b, p1[r + 2], p1[r + 3]); }
    const float m = max2f(a, b);
    auto rr = __builtin_amdgcn_permlane32_swap(__float_as_uint(m), __float_as_uint(m), false, false);
    return max2f(__uint_as_float(rr[0]), __uint_as_float(rr[1]));
}
__device__ __forceinline__ void pv(f32x16* o, int vb, h8 pa0, h8 pa1, h8 pa2, h8 pa3) {
#pragma unroll
    for (int d0 = 0; d0 < 2; ++d0) { s16x4 lo[4], hi[4];
#pragma unroll
        for (int ks = 0; ks < 4; ++ks) {
            asm volatile("ds_read_b64_tr_b16 %0,%1 offset:%c2" : "=&v"(lo[ks]) : "v"(vb), "i"(d0 * 4096 + ks * 1024) : "memory");
            asm volatile("ds_read_b64_tr_b16 %0,%1 offset:%c2" : "=&v"(hi[ks]) : "v"(vb), "i"(d0 * 4096 + ks * 1024 + 512) : "memory"); }
        asm volatile("s_waitcnt lgkmcnt(0)" ::: "memory"); SBAR();
#define FA_PK(k) __builtin_bit_cast(h8, (s16x8){lo[k][0], lo[k][1], lo[k][2], lo[k][3], hi[k][0], hi[k][1], hi[k][2], hi[k][3]})
        o[d0] = __builtin_amdgcn_mfma_f32_32x32x16_f16(pa0, FA_PK(0), o[d0], 0, 0, 0);
        o[d0] = __builtin_amdgcn_mfma_f32_32x32x16_f16(pa1, FA_PK(1), o[d0], 0, 0, 0);
        o[d0] = __builtin_amdgcn_mfma_f32_32x32x16_f16(pa2, FA_PK(2), o[d0], 0, 0, 0);
        o[d0] = __builtin_amdgcn_mfma_f32_32x32x16_f16(pa3, FA_PK(3), o[d0], 0, 0, 0);
#undef FA_PK
    }
}
__device__ __forceinline__ void table_mask(f32x16& p0, f32x16& p1, const LAS float* base) {
#pragma unroll
    for (int g = 0; g < 4; ++g) {
#pragma unroll
        for (int e = 0; e < 4; ++e) { const int r = 4 * g + e; p0[r] += base[e + 8 * g]; p1[r] += base[32 + e + 8 * g]; }

    }
}
__device__ __forceinline__ void past_mask_far(f32x16& p0, f32x16& p1, int t, unsigned selmask, float c31) {
    const float cin = ((selmask >> (t >> 2)) & 1u) != 0u ? c31 : -INFINITY;
#pragma unroll
    for (int r = 0; r < 16; ++r) { p0[r] += cin; p1[r] += cin; }
}
__device__ __forceinline__ void past_mask(f32x16& p0, f32x16& p1, int t, int qt, int wid, int r32, int hi, unsigned selmask, float c31, const LAS float* lutE) {
    const int j = t >> 2, ti = t & 3;
    if (j == qt - 1 && 32 * wid + 193 - 64 * ti < 113) {
        const bool sel = ((selmask >> j) & 1u) != 0u;
        const int dbase = 256 + wid * 32 + r32 - 64 * ti - 4 * hi;
        table_mask(p0, p1, sel ? lutE + (511 - dbase) : lutE + 512);
    } else past_mask_far(p0, p1, t, selmask, c31);
}
__device__ __forceinline__ void band_mask(f32x16& p0, f32x16& p1, int jb, int qrel, int hi, const LAS float* lutE) { table_mask(p0, p1, lutE + (511 - (qrel - 64 * jb - 4 * hi))); }

template <bool MOBA, int THRL>
__device__ __forceinline__ void attn_unit(LAS unsigned char* shm, const half_t* Qu, int QP, const half_t* Kh, const half_t* Vh, int KP, int NT, int qt,
                                          const float* km, const LAS float* lutw, half_t* Yg, const half_t* Zg, float* ssyp,
                                          h8 (&qr)[4], bool qpre, bool resident, const half_t* nextQ, int nextQP) {
    int tid_ = threadIdx.x; asm volatile("" : "+v"(tid_));
    const int tid = tid_, lane = tid & 63, r32 = lane & 31, hi = lane >> 5; const int wid = __builtin_amdgcn_readfirstlane(tid >> 6);
    const half_t* Qw = Qu + (size_t)(wid * 32) * QP;
    const unsigned lds0 = (unsigned)(uintptr_t)shm;
    LAS float* wsf = (LAS float*)(shm + LDS_WS) + wid * 64;
    const half_t* ksrc = Kh + (size_t)lane * KP + wid * 8;
    const half_t* vsrc = Vh + (size_t)(16 * (wid & 3) + (lane >> 2)) * KP + (wid >> 2) * 32 + (lane & 3) * 8;
    const unsigned kdst = lds0 + LDS_K + wid * 1024, vdst = lds0 + LDS_V + wid * 1024;
#define DMA_K(t, slot) glds16(ksrc + (size_t)(t) * KVBLK * KP, (unsigned)__builtin_amdgcn_readfirstlane(kdst + (slot)))
#define DMA_V(t, slot) glds16(vsrc + (size_t)(t) * KVBLK * KP, (unsigned)__builtin_amdgcn_readfirstlane(vdst + (slot)))
    const int vb0 = (int)(lds0 + LDS_V) + ((lane >> 4) & 1) * 32 + (lane & 3) * 8 + (4 * hi + ((lane & 15) >> 2)) * 64;
    const lds_cptr Kbase = shm + LDS_K; h8 kf[8];
    const lds_cptr kp0 = shm + LDS_K + hi * 1024 + r32 * 16; const lds_cptr vp0 = shm + LDS_V + ((lane >> 4) & 1) * 32 + (lane & 3) * 8 + (4 * hi + ((lane & 15) >> 2)) * 64;
    if (!resident) { DMA_K(0, 0); DMA_V(0, 0); DMA_K(1, SLOTB); }
    if (!qpre) {
#pragma unroll
        for (int d0 = 0; d0 < 4; ++d0) qr[d0] = *(const h8*)(Qw + (size_t)r32 * QP + d0 * 16 + hi * 8);
    }
    unsigned selmask = 0u; float c31 = 0.f;
    if (MOBA) {
        c31 = lutw[511 - 127];
        float gs[8];
        if (qt > 0) {
            f32x16 gacc = f32x16{};
#pragma unroll
            for (int d0 = 0; d0 < 4; ++d0) { h8 ka = h8{};
                if (r32 < qt) { const float* kp = km + r32 * 384 + d0 * 16 + hi * 8; const f32x4 k0 = *(const f32x4*)kp, k1 = *(const f32x4*)(kp + 4);
                    u32x4 w; w.x = pkh(k0[0] * (1.0f / 256.0f), k0[1] * (1.0f / 256.0f)); w.y = pkh(k0[2] * (1.0f / 256.0f), k0[3] * (1.0f / 256.0f));
                    w.z = pkh(k1[0] * (1.0f / 256.0f), k1[1] * (1.0f / 256.0f)); w.w = pkh(k1[2] * (1.0f / 256.0f), k1[3] * (1.0f / 256.0f)); ka = __builtin_bit_cast(h8, w); }
                gacc = __builtin_amdgcn_mfma_f32_32x32x16_f16(ka, qr[d0], gacc, 0, 0, 0); }
#pragma unroll
            for (int i = 0; i < 4; ++i) { auto rr = __builtin_amdgcn_permlane32_swap(__float_as_uint(gacc[i]), __float_as_uint(gacc[i]), false, false);
                const float own = gacc[i], oth = hi == 0 ? __uint_as_float(rr[1]) : __uint_as_float(rr[0]);
                gs[i] = hi == 0 ? own : oth; gs[4 + i] = hi == 0 ? oth : own; }
        } else {
#pragma unroll
            for (int j = 0; j < 8; ++j) gs[j] = 0.f;
        }
#pragma unroll
        for (int j = 0; j < 7; ++j) if (j >= qt) gs[j] = -INFINITY;
#pragma unroll
        for (int j = 0; j < 7; ++j) { int cnt = 0;
#pragma unroll
            for (int k = 0; k < 7; ++k) if (k != j) cnt += (k < j ? gs[k] >= gs[j] : gs[k] > gs[j]) ? 1 : 0;
            if (j < qt && cnt < 3) selmask |= 1u << j; }
    }
    float mhat = 0.f, l_reg = 0.f; f32x16 o[2]; o[0] = f32x16{}; o[1] = f32x16{}; f32x16 negm = f32x16{}; asm volatile("" : "+v"(negm));
    const int qrel = wid * 32 + r32;
#define CMASK(P0, P1, t) do { if (MOBA) { const int jb_ = (t) - (NT - 4); if (jb_ >= 0) band_mask(P0, P1, jb_, qrel, hi, lutw); else past_mask(P0, P1, (t), qt, wid, r32, hi, selmask, c31, lutw); } } while (0)
    bool resc = false;
#define START(P0, P1) do { const float rm = max2f(rowmax(P0, P1), -1000.0f); resc = false; \
    { const float dl = rm; mhat = fadd_s(mhat, dl); \
      _Pragma("unroll") for (int r = 0; r < 16; ++r) { P0[r] = fsub_s(P0[r], dl); P1[r] = fsub_s(P1[r], dl); } \
      _Pragma("unroll") for (int r = 0; r < 16; ++r) negm[r] = -mhat; asm volatile("" : "+v"(negm)); } \
    _Pragma("unroll") for (int r = 0; r < 16; ++r) P0[r] = __builtin_amdgcn_exp2f(P0[r]); } while (0)
#define RESC() do { if (resc) { asm volatile("s_waitcnt lgkmcnt(0)" ::: "memory"); \
      _Pragma("unroll") for (int d_ = 0; d_ < 2; ++d_) _Pragma("unroll") for (int r = 0; r < 16; ++r) o[d_][r] *= wsf[crow(r, hi)]; } } while (0)
    f32x16 pA0, pA1, pB0, pB1;
#define ROT() do { } while (0)
    if (!resident) DMA_K(2, 2 * SLOTB);
    WAIT_BAR(3);
    qkt(pA0, pA1, Kbase, qr, negm, r32, hi); asm volatile("s_nop 15\n\ts_nop 7" : "+v"(pA0), "+v"(pA1)); CMASK(pA0, pA1, 0);
    START(pA0, pA1);
    _Pragma("unroll") for (int r = 0; r < 16; ++r) pA1[r] = __builtin_amdgcn_exp2f(pA1[r]);
    WAIT_BAR(0);
    if (!resident) { DMA_K(3, 3 * SLOTB); DMA_V(1, SLOTB); DMA_V(2, 2 * SLOTB); }
    kload8(kf, kp0 + SLOTB);
    WAIT_BAR(3);
    s16x4 vlo[8], vhi[8]; u32x4 pw0, pw1, pw2, pw3;
#define PKW(P, B) pkh(P[B], P[B + 1])
#define PAF(k) __builtin_bit_cast(h8, pw##k)
#define VFR(i) __builtin_bit_cast(h8, (s16x8){vlo[i][0], vlo[i][1], vlo[i][2], vlo[i][3], vhi[i][0], vhi[i][1], vhi[i][2], vhi[i][3]})
#define PIN(x) asm volatile("" : "+v"(x))
#define MX3(a, b, c) __builtin_fmaxf(__builtin_fmaxf((a), (b)), (c))
#define GAPA(MF, A0, A1, A2, A3, W0, W1, PW) do { MF; sacc += A0; sacc += A1; sacc += A2; sacc += A3; PIN(sacc); W0; W1; PIN(PW); SBAR(); } while (0)
#define EX(v) __builtin_amdgcn_exp2f(v)
#define GAPB(MF, X, B) do { MF; X[B] = EX(X[B]); X[B + 1] = EX(X[B + 1]); X[B + 2] = EX(X[B + 2]); X[B + 3] = EX(X[B + 3]); PIN(X); SBAR(); } while (0)
#define VRD(i) do { vlo[i] = vtr(vp_ + (((i) >> 2) * 4096 + ((i) & 3) * 1024)); vhi[i] = vtr(vp_ + (((i) >> 2) * 4096 + ((i) & 3) * 1024 + 512)); } while (0)
#define KRD(G, j, t) do { if (G) { kload2(kf, kp0 + ((((t) + 1) & 3) * SLOTB), j); SBAR(); } } while (0)
#define MF16 __builtin_amdgcn_mfma_f32_32x32x16_f16
#define STEP(C0, C1, P0, P1, t, GK, GV, GL) do { SBAR(); \
    const lds_cptr vp_ = vp0 + ((((t) - 1) & 3) * SLOTB); \
    VRD(0); SBAR(); float sacc = (P0[0] + P0[1]); \
    GAPA(C0 = MF16(kf[0], qr[0], negm, 0, 0, 0), P0[2], P0[3], P0[4], P0[5],     pw0[0] = PKW(P0, 0), pw0[1] = PKW(P0, 2), pw0); \
    VRD(4); SBAR(); GAPA(C1 = MF16(kf[1], qr[0], negm, 0, 0, 0), P0[6], P0[7], P0[8], P0[9],     pw0[2] = PKW(P0, 4), pw0[3] = PKW(P0, 6), pw0); \
    VRD(1); SBAR(); GAPA(C0 = MF16(kf[2], qr[1], C0, 0, 0, 0),   P0[10], P0[11], P0[12], P0[13], pw1[0] = PKW(P0, 8), pw1[1] = PKW(P0, 10), pw1); \
    VRD(5); SBAR(); GAPA(C1 = MF16(kf[3], qr[1], C1, 0, 0, 0),   P0[14], P0[15], P1[0], P1[1],   pw1[2] = PKW(P0, 12), pw1[3] = PKW(P0, 14), pw1); \
    VRD(2); SBAR(); GAPA(C0 = MF16(kf[4], qr[2], C0, 0, 0, 0),   P1[2], P1[3], P1[4], P1[5],     pw2[0] = PKW(P1, 0), pw2[1] = PKW(P1, 2), pw2); \
    VRD(6); SBAR(); GAPA(C1 = MF16(kf[5], qr[2], C1, 0, 0, 0),   P1[6], P1[7], P1[8], P1[9],     pw2[2] = PKW(P1, 4), pw2[3] = PKW(P1, 6), pw2); \
    VRD(3); SBAR(); GAPA(C0 = MF16(kf[6], qr[3], C0, 0, 0, 0),   P1[10], P1[11], P1[12], P1[13], pw3[0] = PKW(P1, 8), pw3[1] = PKW(P1, 10), pw3); \
    VRD(7); SBAR(); GAPA(C1 = MF16(kf[7], qr[3], C1, 0, 0, 0),   P1[14], P1[15], 0.f, 0.f,       pw3[2] = PKW(P1, 12), pw3[3] = PKW(P1, 14), pw3); \
    l_reg += sacc; \
    if ((GK) && !resident) { DMA_K((t) + 3, (((t) + 3) & 3) * SLOTB); } if ((GV) && !resident) { DMA_V((t) + 2, (((t) + 2) & 3) * SLOTB); } \
    CMASK(C0, C1, t); \
    { float a = MX3(C0[0], C0[1], C1[0]), b = MX3(C0[2], C0[3], C1[1]); a = MX3(a, C1[2], C1[3]); \
      _Pragma("unroll") for (int r = 4; r < 16; r += 4) { a = MX3(a, C0[r], C0[r + 1]); b = MX3(b, C0[r + 2], C0[r + 3]); a = MX3(a, C1[r], C1[r + 1]); b = MX3(b, C1[r + 2], C1[r + 3]); } \
      float rm = __builtin_fmaxf(a, b); { auto rr = __builtin_amdgcn_permlane32_swap(__float_as_uint(rm), __float_as_uint(rm), false, false); rm = __builtin_fmaxf(__uint_as_float(rr[0]), __uint_as_float(rr[1])); } \
      resc = false; \
      if (__builtin_expect(__any(rm > (float)THRL), 0)) { const float dl = __builtin_fmaxf(rm, 0.f); mhat += dl; \
        _Pragma("unroll") for (int r = 0; r < 16; ++r) { C0[r] -= dl; C1[r] -= dl; } \
        _Pragma("unroll") for (int r = 0; r < 16; ++r) negm[r] = -mhat; asm volatile("" : "+v"(negm)); \
        const float f = __builtin_amdgcn_exp2f(-dl); l_reg *= f; if (hi == 0) wsf[r32] = f; resc = true; } } \
    SBAR(); \
    GAPB(o[0] = MF16(PAF(0), VFR(0), o[0], 0, 0, 0), C0, 0); \
    GAPB(o[1] = MF16(PAF(0), VFR(4), o[1], 0, 0, 0), C0, 4); \
    KRD(GL, 0, t); GAPB(o[0] = MF16(PAF(1), VFR(1), o[0], 0, 0, 0), C0, 8); \
    KRD(GL, 1, t); GAPB(o[1] = MF16(PAF(1), VFR(5), o[1], 0, 0, 0), C0, 12); \
    KRD(GL, 2, t); GAPB(o[0] = MF16(PAF(2), VFR(2), o[0], 0, 0, 0), C1, 0); \
    KRD(GL, 3, t); GAPB(o[1] = MF16(PAF(2), VFR(6), o[1], 0, 0, 0), C1, 4); \
    GAPB(o[0] = MF16(PAF(3), VFR(3), o[0], 0, 0, 0), C1, 8); \
    GAPB(o[1] = MF16(PAF(3), VFR(7), o[1], 0, 0, 0), C1, 12); \
    } while (0)
    int t = 1;
#undef CMASK
#define CMASK(P0, P1, t) do { if (MOBA) past_mask_far(P0, P1, (t), selmask, c31); } while (0)
    for (; t + 7 < NT; t += 2) {
        STEP(pB0, pB1, pA0, pA1, t, true, true, true);     WAIT_BAR(3); RESC(); ROT();
        STEP(pA0, pA1, pB0, pB1, t + 1, true, true, true); WAIT_BAR(3); RESC(); ROT();
    }
#undef CMASK
#define CMASK(P0, P1, t) do { if (MOBA) { const int jb_ = (t) - (NT - 4); if (jb_ >= 0) band_mask(P0, P1, jb_, qrel, hi, lutw); else past_mask(P0, P1, (t), qt, wid, r32, hi, selmask, c31, lutw); } } while (0)
#define ENDW(tt) do { if ((tt) + 3 < NT) { WAIT_BAR(3); } else if ((tt) + 2 < NT) { WAIT_BAR(2); } else { WAIT_BAR(0); } } while (0)
    for (; t + 1 < NT; t += 2) {
        STEP(pB0, pB1, pA0, pA1, t, (t + 3 < NT), (t + 2 < NT), (t + 1 < NT));     ENDW(t);     RESC(); ROT();
        STEP(pA0, pA1, pB0, pB1, t + 1, (t + 4 < NT), (t + 3 < NT), (t + 2 < NT)); ENDW(t + 1); RESC(); ROT();
    }
    STEP(pB0, pB1, pA0, pA1, NT - 1, false, false, false); RESC();
    if (nextQ) {
        const half_t* nq = nextQ + (size_t)(wid * 32 + r32) * nextQP + hi * 8;
#pragma unroll
        for (int d0 = 0; d0 < 4; ++d0) qr[d0] = *(const h8*)(nq + d0 * 16);
    }
    h8 zv[4];
    { const half_t* zp = Zg + (size_t)(wid * 32 + (lane >> 1)) * PP + (lane & 1) * 32;
#pragma unroll
      for (int c = 0; c < 4; ++c) zv[c] = *(const h8*)(zp + c * 8); }
    { float sacc = pB0[0] + pB0[1]; _Pragma("unroll") for (int r = 2; r < 16; ++r) sacc += pB0[r]; _Pragma("unroll") for (int r = 0; r < 16; ++r) sacc += pB1[r]; l_reg += sacc;
      pw0 = (u32x4){PKW(pB0, 0), PKW(pB0, 2), PKW(pB0, 4), PKW(pB0, 6)}; pw1 = (u32x4){PKW(pB0, 8), PKW(pB0, 10), PKW(pB0, 12), PKW(pB0, 14)}; pw2 = (u32x4){PKW(pB1, 0), PKW(pB1, 2), PKW(pB1, 4), PKW(pB1, 6)}; pw3 = (u32x4){PKW(pB1, 8), PKW(pB1, 10), PKW(pB1, 12), PKW(pB1, 14)};
      SBAR(); pv(o, vb0 + ((NT - 1) & 3) * SLOTB, PAF(0), PAF(1), PAF(2), PAF(3)); }
#undef PKW
#undef PAF
#undef VFR
#undef PIN
#undef MX3
#undef GAPA
#undef GAPB
#undef EX
#undef VRD
#undef KRD
#undef MF16
#undef STEP
#undef ENDW
    { auto rr = __builtin_amdgcn_permlane32_swap(__float_as_uint(l_reg), __float_as_uint(l_reg), false, false); l_reg = __uint_as_float(rr[0]) + __uint_as_float(rr[1]); }
    if (hi == 0) wsf[32 + r32] = __builtin_amdgcn_rcpf(l_reg);
    LAS float* stg = (LAS float*)(shm + LDS_STG + wid * STG_W);
#pragma unroll
    for (int r = 0; r < 16; ++r) { const int q = crow(r, hi); stg[q * STG_ROW + r32] = o[0][r]; stg[q * STG_ROW + 32 + r32] = o[1][r]; }
    asm volatile("s_waitcnt lgkmcnt(0)" ::: "memory");
    { const int row = lane >> 1, hf = lane & 1; const LAS float* sp = stg + row * STG_ROW + hf * 32; const float inv = wsf[32 + row];
      half_t* yp = Yg + (size_t)(wid * 32 + row) * DM + hf * 32; float ss = 0.f; f32x2 ss2 = {0.f, 0.f};
#pragma unroll
      for (int c = 0; c < 4; ++c) { const f32x4 v0 = *(const LAS f32x4*)(sp + c * 8) * inv, v1 = *(const LAS f32x4*)(sp + c * 8 + 4) * inv; const h8 z = zv[c];
          ss2 = (f32x2){v0[0], v0[1]} * (f32x2){v0[0], v0[1]} + ss2; ss2 = (f32x2){v0[2], v0[3]} * (f32x2){v0[2], v0[3]} + ss2;
          ss2 = (f32x2){v1[0], v1[1]} * (f32x2){v1[0], v1[1]} + ss2; ss2 = (f32x2){v1[2], v1[3]} * (f32x2){v1[2], v1[3]} + ss2;
          u32x4 w; w.x = pkh(v0[0] * (float)z[0], v0[1] * (float)z[1]); w.y = pkh(v0[2] * (float)z[2], v0[3] * (float)z[3]);
          w.z = pkh(v1[0] * (float)z[4], v1[1] * (float)z[5]); w.w = pkh(v1[2] * (float)z[6], v1[3] * (float)z[7]);
          *(u32x4*)(yp + c * 8) = w; }
      ss = ss2.x + ss2.y;
      ss += __shfl_xor(ss, 1);
      if (hf == 0) ssyp[(size_t)(wid * 32 + row) * 16] = ss; }
    asm volatile("s_waitcnt lgkmcnt(0)\n\ts_barrier" ::: "memory");
#undef DMA_K
#undef DMA_V
#undef CMASK
#undef START
#undef RESC
#undef ROT
}
#undef SBAR
#undef WAIT_BAR
}

__device__ __forceinline__ void gmlp_unit(LAS unsigned char* lds, int tid, const half_t* proj, const half_t* wsp_lg, const float* lng, const float* lnb, const float* spb, half_t* Y, float* ssy, int bc2, int g) {
    asm volatile("" : "+v"(tid));
    const int lane = tid & 63, wid = __builtin_amdgcn_readfirstlane(tid >> 6);
    const int r0 = bc2 * 256;
    const int s = tid >> 2, qd = tid & 3;
    const int tl = lane >> 2, cq = lane & 3, t = 16 * wid + tl;
    h8 vv[2][2], uu[2][2], zz[2][2];
#pragma unroll
    for (int c = 0; c < 2; ++c) { const half_t* vp = proj + (size_t)(r0 + c * 128 + s) * PP + C_V + g * 64 + qd * 16; vv[c][0] = *(const h8*)vp; vv[c][1] = *(const h8*)(vp + 8); }
#pragma unroll
    for (int c = 0; c < 2; ++c) { const half_t* up = proj + (size_t)(r0 + c * 128 + t) * PP + C_U + g * 64 + cq * 16; const half_t* zp = proj + (size_t)(r0 + c * 128 + t) * PP + C_Z + g * 64 + cq * 16;
        uu[c][0] = *(const h8*)up; uu[c][1] = *(const h8*)(up + 8); zz[c][0] = *(const h8*)zp; zz[c][1] = *(const h8*)(zp + 8); }
    float lg[16], lb[16];
#pragma unroll
    for (int e = 0; e < 16; ++e) { lg[e] = lng[qd * 16 + e]; lb[e] = lnb[qd * 16 + e]; }
    const int r16 = lane & 15, kq = lane >> 4;
    const int nks = (16 * wid + 15) / 32 + 1;
    h8 af[4];
#pragma unroll
    for (int ks = 0; ks < 4; ++ks) af[ks] = *(const h8*)(wsp_lg + (size_t)(16 * wid + r16) * 128 + (ks < nks ? ks : 0) * 32 + kq * 8);
    const float bsp = spb[t];
#pragma unroll
    for (int c = 0; c < 2; ++c) {
        LAS half_t* vnt = (LAS half_t*)(lds + GM_VNT + c * GM_VNT_BYTES);
        float x[16]; float sum = 0.f;
#pragma unroll
        for (int e = 0; e < 8; ++e) { x[e] = (float)vv[c][0][e]; x[8 + e] = (float)vv[c][1][e]; }
#pragma unroll
        for (int e = 0; e < 16; ++e) sum += x[e];
        sum += __shfl_xor(sum, 1); sum += __shfl_xor(sum, 2);
        const float mu = sum * (1.0f / 64.0f); float var = 0.f;
#pragma unroll
        for (int e = 0; e < 16; ++e) { x[e] -= mu; var += x[e] * x[e]; }
        var += __shfl_xor(var, 1); var += __shfl_xor(var, 2);
        const float rs = __builtin_amdgcn_rsqf(var * (1.0f / 64.0f) + EPS);
#pragma unroll
        for (int e = 0; e < 16; ++e) vnt[(qd * 16 + e) * GM_VNT_ROW + s] = (half_t)(x[e] * rs * lg[e] + lb[e]);
    }
    __syncthreads();
    f32x4 acc[2][4];
#pragma unroll
    for (int c = 0; c < 2; ++c)
#pragma unroll
        for (int n = 0; n < 4; ++n) acc[c][n] = (f32x4){0.f, 0.f, 0.f, 0.f};
#pragma unroll
    for (int ks = 0; ks < 4; ++ks) {
        if (ks < nks) {
#pragma unroll
            for (int c = 0; c < 2; ++c)
#pragma unroll
                for (int n = 0; n < 4; ++n) { const h8 bf = *(const LAS h8*)(lds + GM_VNT + c * GM_VNT_BYTES + ((16 * n + r16) * GM_VNT_ROW + ks * 32 + kq * 8) * 2);
                    acc[c][n] = __builtin_amdgcn_mfma_f32_16x16x32_f16(af[ks], bf, acc[c][n], 0, 0, 0); }
        }
    }
#pragma unroll
    for (int c = 0; c < 2; ++c) {
        LAS float* stg = (LAS float*)(lds + GM_STAGE) + (c * 8 + wid) * 16 * AT_STG_ROW;
#pragma unroll
        for (int n = 0; n < 4; ++n)
#pragma unroll
            for (int e = 0; e < 4; ++e) stg[(4 * kq + e) * AT_STG_ROW + 16 * n + r16] = acc[c][n][e];
    }
    asm volatile("s_waitcnt lgkmcnt(0)" ::: "memory");
#pragma unroll
    for (int c = 0; c < 2; ++c) {
        const LAS float* sp = (const LAS float*)(lds + GM_STAGE) + (c * 8 + wid) * 16 * AT_STG_ROW + tl * AT_STG_ROW + cq * 16;
        const int row = r0 + c * 128 + t; half_t* yp = Y + (size_t)row * DM + g * 64 + cq * 16; float ss = 0.f;
#pragma unroll
        for (int k = 0; k < 2; ++k) { const f32x4 s0 = *(const LAS f32x4*)(sp + k * 8), s1 = *(const LAS f32x4*)(sp + k * 8 + 4); const h8 u = uu[c][k], z = zz[c][k]; float yv[8];
#pragma unroll
            for (int e = 0; e < 4; ++e) { yv[e] = (float)u[e] * (s0[e] + bsp); yv[4 + e] = (float)u[4 + e] * (s1[e] + bsp); }
#pragma unroll
            for (int e = 0; e < 8; ++e) ss += yv[e] * yv[e];
            u32x4 w; w.x = pkh(yv[0] * (float)z[0], yv[1] * (float)z[1]); w.y = pkh(yv[2] * (float)z[2], yv[3] * (float)z[3]);
            w.z = pkh(yv[4] * (float)z[4], yv[5] * (float)z[5]); w.w = pkh(yv[6] * (float)z[6], yv[7] * (float)z[7]);
            *(u32x4*)(yp + k * 8) = w; }
        ss += __shfl_xor(ss, 1); ss += __shfl_xor(ss, 2);
        if (cq == 0) ssy[(size_t)row * 16 + g] = ss;
    }
    __syncthreads();
}

__device__ __forceinline__ void gmlp_chain3(LAS unsigned char* lds, int tid, const half_t* proj, const half_t* wsp_l, const float* lng_l, const float* lnb_l, const float* spb_l, half_t* Y, float* ssy, int grp, int rank) {
    asm volatile("" : "+v"(tid));
    const int lane = tid & 63, wid = __builtin_amdgcn_readfirstlane(tid >> 6);
    const int s = tid >> 2, qd = tid & 3;
    const int tl = lane >> 2, cq = lane & 3, t = 16 * wid + tl;
    const int r16 = lane & 15, kq = lane >> 4;
    const int nks = (16 * wid + 15) / 32 + 1;
    h8 vv[2][2], uu[2][2], zz[2][2], af[4], afn[4]; float lg[16], lb[16]; float bsp;
#define GM_UNIT(k) const int ug_ = rank * 3 + (k), g_ = ug_ >> 4, r0_ = (16 * grp + (ug_ & 15)) * 256
#define GM_LOADV(k, AF) do { GM_UNIT(k); \
        _Pragma("unroll") for (int c = 0; c < 2; ++c) { const half_t* vp = proj + (size_t)(r0_ + c * 128 + s) * PP + C_V + g_ * 64 + qd * 16; vv[c][0] = *(const h8*)vp; vv[c][1] = *(const h8*)(vp + 8); } \
        _Pragma("unroll") for (int e = 0; e < 16; ++e) { lg[e] = lng_l[g_ * 64 + qd * 16 + e]; lb[e] = lnb_l[g_ * 64 + qd * 16 + e]; } \
        _Pragma("unroll") for (int ks = 0; ks < 4; ++ks) AF[ks] = *(const h8*)(wsp_l + (size_t)g_ * 128 * 128 + (size_t)(16 * wid + r16) * 128 + (ks < nks ? ks : 0) * 32 + kq * 8); } while (0)
#define GM_LOADUZ(k) do { GM_UNIT(k); \
        _Pragma("unroll") for (int c = 0; c < 2; ++c) { const half_t* up = proj + (size_t)(r0_ + c * 128 + t) * PP + C_U + g_ * 64 + cq * 16; const half_t* zp = proj + (size_t)(r0_ + c * 128 + t) * PP + C_Z + g_ * 64 + cq * 16; \
            uu[c][0] = *(const h8*)up; uu[c][1] = *(const h8*)(up + 8); zz[c][0] = *(const h8*)zp; zz[c][1] = *(const h8*)(zp + 8); } \
        bsp = spb_l[g_ * 128 + t]; } while (0)
    GM_LOADV(0, af); GM_LOADUZ(0);
#pragma unroll
    for (int k = 0; k < 3; ++k) {
        GM_UNIT(k);
#pragma unroll
        for (int c = 0; c < 2; ++c) {
            LAS half_t* vnt = (LAS half_t*)(lds + GM_VNT + c * GM_VNT_BYTES);
            float x[16]; float sum = 0.f;
#pragma unroll
            for (int e = 0; e < 8; ++e) { x[e] = (float)vv[c][0][e]; x[8 + e] = (float)vv[c][1][e]; }
#pragma unroll
            for (int e = 0; e < 16; ++e) sum += x[e];
            sum += __shfl_xor(sum, 1); sum += __shfl_xor(sum, 2);
            const float mu = sum * (1.0f / 64.0f); float var = 0.f;
#pragma unroll
            for (int e = 0; e < 16; ++e) { x[e] -= mu; var += x[e] * x[e]; }
            var += __shfl_xor(var, 1); var += __shfl_xor(var, 2);
            const float rs = __builtin_amdgcn_rsqf(var * (1.0f / 64.0f) + EPS);
#pragma unroll
            for (int e = 0; e < 16; ++e) vnt[(qd * 16 + e) * GM_VNT_ROW + s] = (half_t)(x[e] * rs * lg[e] + lb[e]);
        }
        __syncthreads();
        if (k < 2) GM_LOADV(k + 1, afn);
        f32x4 acc[2][4];
#pragma unroll
        for (int c = 0; c < 2; ++c)
#pragma unroll
            for (int n = 0; n < 4; ++n) acc[c][n] = (f32x4){0.f, 0.f, 0.f, 0.f};
#pragma unroll
        for (int ks = 0; ks < 4; ++ks) {
            if (ks < nks) {
#pragma unroll
                for (int c = 0; c < 2; ++c)
#pragma unroll
                    for (int n = 0; n < 4; ++n) { const h8 bf = *(const LAS h8*)(lds + GM_VNT + c * GM_VNT_BYTES + ((16 * n + r16) * GM_VNT_ROW + ks * 32 + kq * 8) * 2);
                        acc[c][n] = __builtin_amdgcn_mfma_f32_16x16x32_f16(af[ks], bf, acc[c][n], 0, 0, 0); }
            }
        }
#pragma unroll
        for (int c = 0; c < 2; ++c) {
            LAS float* stg = (LAS float*)(lds + GM_STAGE) + (c * 8 + wid) * 16 * AT_STG_ROW;
#pragma unroll
            for (int n = 0; n < 4; ++n)
#pragma unroll
                for (int e = 0; e < 4; ++e) stg[(4 * kq + e) * AT_STG_ROW + 16 * n + r16] = acc[c][n][e];
        }
        asm volatile("s_waitcnt lgkmcnt(0)" ::: "memory");
#pragma unroll
        for (int c = 0; c < 2; ++c) {
            const LAS float* sp = (const LAS float*)(lds + GM_STAGE) + (c * 8 + wid) * 16 * AT_STG_ROW + tl * AT_STG_ROW + cq * 16;
            const int row = r0_ + c * 128 + t; half_t* yp = Y + (size_t)row * DM + g_ * 64 + cq * 16; float ss = 0.f;
#pragma unroll
            for (int j = 0; j < 2; ++j) { const f32x4 s0 = *(const LAS f32x4*)(sp + j * 8), s1 = *(const LAS f32x4*)(sp + j * 8 + 4); const h8 u = uu[c][j], z = zz[c][j]; float yv[8];
#pragma unroll
                for (int e = 0; e < 4; ++e) { yv[e] = (float)u[e] * (s0[e] + bsp); yv[4 + e] = (float)u[4 + e] * (s1[e] + bsp); }
#pragma unroll
                for (int e = 0; e < 8; ++e) ss += yv[e] * yv[e];
                u32x4 w; w.x = pkh(yv[0] * (float)z[0], yv[1] * (float)z[1]); w.y = pkh(yv[2] * (float)z[2], yv[3] * (float)z[3]);
                w.z = pkh(yv[4] * (float)z[4], yv[5] * (float)z[5]); w.w = pkh(yv[6] * (float)z[6], yv[7] * (float)z[7]);
                *(u32x4*)(yp + j * 8) = w; }
            ss += __shfl_xor(ss, 1); ss += __shfl_xor(ss, 2);
            if (cq == 0) ssy[(size_t)row * 16 + g_] = ss;
        }
        if (k < 2) { GM_LOADUZ(k + 1);
#pragma unroll
            for (int ks = 0; ks < 4; ++ks) af[ks] = afn[ks]; }
        __syncthreads();
    }
#undef GM_UNIT
#undef GM_LOADV
#undef GM_LOADUZ
}

constexpr int NU_MOBA = 96 * 8, NU_MEM = 64 * 8, NU_GMLP = 128 * 6, NU_ALL = NU_MOBA + NU_MEM + NU_GMLP;
__device__ __forceinline__ void mixer_phase_fast(Frame& F, const Args& a, int l, int qidx) {
    static_assert(fa::LDS_END <= MISC_OFF, "attention LDS map");
    LAS float* lut = (LAS float*)(F.lds + fa::LDS_LUT);
    { const f32x4* src = (const f32x4*)(a.ws + WS_LUT); static_assert(fa::LUT_N == 768, "table size");
      for (int i = F.tid; i < 6 * fa::LUT_N / 4; i += NTHR) ((LAS f32x4*)lut)[i] = src[i]; }
    __syncthreads();
    volatile LAS unsigned* MISC = (volatile LAS unsigned*)(F.lds + MISC_OFF);
    const bool deal = F.G == 256;
    const int grp = F.bid & 7;
    unsigned* qhead = F.ctl + CW_QUEUE + 64 * (deal ? qidx * 8 + grp : 24 + qidx);
    const half_t* mkv_l = F.mkv + (size_t)l * MMEM * NKV;
    const int vcu = (F.bid & 7) * 32 + (F.bid >> 3);
    h8 qr[4] = {};
    for (int it = 0;; ++it) {
        int u;
        if (deal && it < 5) {
            if (it < 3) { const int gi = vcu >> 3, tri = vcu & 7; int bsel, qt;
                if (tri < 6) { bsel = tri >> 1; qt = (tri & 1) ? (it == 0 ? 6 : (it == 1 ? 5 : 0)) : (it == 0 ? 7 : (it == 1 ? 2 : 1)); }
                else if (tri == 6) { bsel = it == 1 ? 1 : 0; qt = it == 2 ? 3 : 4; }
                else { bsel = it == 1 ? 1 : 2; qt = it == 0 ? 4 : 3; }
                u = (7 - qt) * 96 + 3 * gi + bsel; }
            else u = NU_MOBA + (vcu >> 2) * 8 + 2 * (vcu & 3) + (it - 3);
        } else if (deal) {
            gmlp_chain3(F.lds, F.tid, F.proj, F.wsp + (size_t)l * 6 * 128 * 128, a.ln_g + l * 384, a.ln_b + l * 384, a.sp_b + l * 6 * 128, F.y, F.ssy, grp, vcu & 31);
            break;
        } else {
            if (F.tid == 0) MISC[16] = __hip_atomic_fetch_add(qhead, 1u, __ATOMIC_RELAXED, __HIP_MEMORY_SCOPE_AGENT);
            __syncthreads();
            u = __builtin_amdgcn_readfirstlane((int)MISC[16]);
            if (u >= NU_ALL) break;
        }
        if (u < NU_MOBA) {
            const int qt = 7 - u / 96, bh = u % 96, b = bh / 6, h = bh % 6; const size_t row0 = (size_t)b * SEQ + qt * 256;
            fa::attn_unit<true, 8>(F.lds, F.proj + row0 * PP + C_QB + h * 64, PP, F.proj + (size_t)b * SEQ * PP + C_KB + h * 64, F.proj + (size_t)b * SEQ * PP + C_VB + h * 64, PP, 4 * qt + 4, qt,
                                   F.kmean + (size_t)(b * 8) * 384 + h * 64, lut + h * fa::LUT_N, F.y + row0 * DM + 384 + h * 64, F.proj + row0 * PP + C_Z + 384 + h * 64, F.ssy + row0 * 16 + 6 + h, qr, false, false, nullptr, 0);
        } else if (u < NU_MOBA + NU_MEM) {
            const int v = u - NU_MOBA, b = v >> 5, h = (v >> 3) & 3, qt = v & 7; const size_t row0 = (size_t)b * SEQ + qt * 256;
            const bool pair1 = deal && it == 3, pair2 = deal && it == 4;
            fa::attn_unit<false, 8>(F.lds, F.proj + row0 * PP + C_QM + h * 64, PP, mkv_l + (size_t)b * MEML * NKV + h * 64, mkv_l + (size_t)b * MEML * NKV + 256 + h * 64, NKV, 4, 0,
                                    nullptr, lut, F.y + row0 * DM + 768 + h * 64, F.proj + row0 * PP + C_Z + 768 + h * 64, F.ssy + row0 * 16 + 12 + h,
                                    qr, pair2, pair2, pair1 ? F.proj + (row0 + 256) * PP + C_QM + h * 64 : nullptr, PP);
        } else {
            const int v = u - NU_MOBA - NU_MEM, g = v >> 7, bc = v & 127;
            gmlp_unit(F.lds, F.tid, F.proj, F.wsp + (size_t)(l * 6 + g) * 128 * 128, a.ln_g + l * 384 + g * 64, a.ln_b + l * 384 + g * 64, a.sp_b + (l * 6 + g) * 128, F.y, F.ssy, bc, g);
        }
    }
}

__device__ __forceinline__ void ynorm_phase(Frame& F) {
    const int gw = F.bid * NWAVES + F.wave, NGW = F.G * NWAVES;
    for (int m = gw; m < MTOK; m += NGW) {
        const float* sp = F.ssy + (size_t)m * 16;
        const int br = F.lane < 24 ? 0 : (F.lane < 48 ? 1 : 2);
        float s = 0.f;
        if (br == 0) s = ((sp[0] + sp[1]) + (sp[2] + sp[3])) + (sp[4] + sp[5]);
        else if (br == 1) s = ((sp[6] + sp[7]) + (sp[8] + sp[9])) + (sp[10] + sp[11]);
        else s = (sp[12] + sp[13]) + (sp[14] + sp[15]);
        const float rs = __builtin_amdgcn_rsqf(s * (br == 2 ? 1.0f / 256.0f : 1.0f / 384.0f) + EPS);
        h8* yp = (h8*)(F.y + (size_t)m * DM + F.lane * 16);
#pragma unroll
        for (int c = 0; c < 2; ++c) { h8 v = yp[c];
#pragma unroll
            for (int e = 0; e < 8; ++e) v[e] = (half_t)((float)v[e] * rs);
            yp[c] = v; }
    }
}
__device__ __forceinline__ void final_phase(Frame& F, const Args& a, float* dst) {
    const bool deal = (F.G & 7) == 0;
    const int gw = deal ? (F.bid >> 3) * NWAVES + F.wave : F.bid * NWAVES + F.wave, NGW = deal ? (F.G >> 3) * NWAVES : F.G * NWAVES;
    const int rbase = deal ? (F.bid & 7) * (MTOK / 8) : 0, rend = deal ? rbase + MTOK / 8 : MTOK;
    const float* ss2 = F.ssx + 2 * MTOK;
    const f32x4* gp = (const f32x4*)a.fin_g + 2 * F.lane; f32x4 g[2][2];
#pragma unroll
    for (int j = 0; j < 2; ++j) { g[j][0] = gp[128 * j]; g[j][1] = gp[128 * j + 1]; }
    for (int m0 = rbase + gw * 8; m0 < rend; m0 += NGW * 8) {
        h8 v[8][2]; float rs[8];
#pragma unroll
        for (int i = 0; i < 8; ++i) { const h8* xp = (const h8*)(F.xh + (size_t)(m0 + i) * DM) + F.lane; rs[i] = ss2[m0 + i]; v[i][0] = __builtin_nontemporal_load(xp); v[i][1] = __builtin_nontemporal_load(xp + 64); }
#pragma unroll
        for (int i = 0; i < 8; ++i) { f32x4* op = (f32x4*)(dst + (size_t)(m0 + i) * DM) + 2 * F.lane; const float r = __builtin_amdgcn_rsqf(rs[i] * (1.0f / DM) + EPS);
#pragma unroll
            for (int j = 0; j < 2; ++j) { const h8 x = v[i][j];
                __builtin_nontemporal_store((f32x4){(float)x[0], (float)x[1], (float)x[2], (float)x[3]} * r * g[j][0], op + 128 * j);
                __builtin_nontemporal_store((f32x4){(float)x[4], (float)x[5], (float)x[6], (float)x[7]} * r * g[j][1], op + 128 * j + 1); } }
    }
}

#define MIXER_PHASE mixer_phase_fast
constexpr int N_PHASES = 8;
__global__ void __launch_bounds__(NTHR, 2) fwd_kernel(Args a_unused) {
    extern __shared__ __attribute__((aligned(16))) unsigned char lds_raw[];
    LAS unsigned char* lds = (LAS unsigned char*)lds_raw;
    volatile LAS unsigned* MISC = (volatile LAS unsigned*)(lds + MISC_OFF);
    for (int u = threadIdx.x; u < 64; u += NTHR) MISC[u] = 0u;
    __syncthreads();
    XcdBarrier bar; GrpBarrier gbar;
    { const Args a = load_args(); bar = xcd_barrier_post((unsigned*)(a.ws + WS_CTL) + CW_BAR, MISC + 8); gbar = grp_barrier_post((unsigned*)(a.ws + WS_CTL), MISC + 10); }
    const bool fusefin = gridDim.x == 256u;
    const bool grouped = (gridDim.x & 7u) == 0u;
#define IN(k) (kargs()->ph_lo <= (k) && (k) < kargs()->ph_hi)
#define SEAM(k) do { if (IN(k) && IN((k) + 1)) { if ((k) > 0 && grouped) grp_barrier(gbar); else xcd_barrier(bar); } } while (0)
    if (IN(0)) { const Args a = load_args(); Frame F = make_frame(lds, a); p0_prologue(F, a);
    } SEAM(0);
    for (int l = 0; l < 2; ++l) {
        const int pb = 3 * l;
        if (IN(pb + 1)) {
            const Args a = load_args(); Frame F = make_frame(lds, a);
            pg8::Gemm g{F.xh, F.bt1 + (size_t)l * NB1 * DM, DM, nullptr}; pg8::Order1 S{F.G, F.bid};
            pg8::EpiProj E{F.proj, F.mkv + (size_t)l * MMEM * NKV, F.ssx + (size_t)l * MTOK, F.kmean + (size_t)l * 128 * 384};
            pg8::gemm_phase<pg8::EpiProj, pg8::Order1, false>(lds, g, S, E);
        } SEAM(pb + 1);
        if (IN(pb + 2)) { const Args a = load_args(); Frame F = make_frame(lds, a); F.kmean += (size_t)l * 128 * 384; MIXER_PHASE(F, a, l, l);
        } SEAM(pb + 2);
        if (IN(pb + 3)) {
            const Args a = load_args(); Frame F = make_frame(lds, a);
            pg8::Gemm g{F.y, F.bt2 + (size_t)l * DM * DM, DM, F.ssy}; pg8::Order2 S{F.G, F.bid};
            if (l == 1 && fusefin) {
                pg8::EpiFinal E{F.xh, a.out, F.ssx + 2 * MTOK, a.fin_g, F.ctl + CW_PANEL, F.ctl + CW_BAR + XB_TMO};
                pg8::gemm_phase<pg8::EpiFinal, pg8::Order2, true>(lds, g, S, E);
            } else {
                pg8::EpiResid E{F.xh, F.xh, F.ssx + (size_t)(l + 1) * MTOK};
                pg8::gemm_phase<pg8::EpiResid, pg8::Order2, true>(lds, g, S, E);
            }
        } if (!(l == 1 && fusefin)) SEAM(pb + 3);
    }
    if (IN(7) && !fusefin) { const Args a = load_args(); Frame F = make_frame(lds, a);
        final_phase(F, a, a.out); }
#undef IN
#undef SEAM
}

#ifndef MK_PER_PHASE
#define MK_PER_PHASE 0
#endif
extern "C" void kernel_launch(void* const* d_in, const int* in_sizes, int n_in, void* d_out, int out_size, void* d_ws, size_t ws_size, hipStream_t stream) {
    static int grid = 0;
    if (grid == 0) {
        if (n_in != 14 || in_sizes[0] != MTOK * DM || out_size != MTOK * DM || ws_size < WS_END) { fprintf(stderr, "kernel_launch: unexpected shapes (n_in %d, in0 %d, out %d, ws %zu)\n", n_in, n_in > 0 ? in_sizes[0] : -1, out_size, ws_size); grid = -1; return; }
        int dev = 0, cus = 0, per_cu = 0;
        if (hipGetDevice(&dev) != hipSuccess || hipDeviceGetAttribute(&cus, hipDeviceAttributeMultiprocessorCount, dev) != hipSuccess) { grid = -1; return; }
        if (hipFuncSetAttribute((const void*)fwd_kernel, hipFuncAttributeMaxDynamicSharedMemorySize, LDS_BYTES) != hipSuccess) { fprintf(stderr, "kernel_launch: hipFuncSetAttribute failed\n"); grid = -1; return; }
        if (hipOccupancyMaxActiveBlocksPerMultiprocessor(&per_cu, (const void*)fwd_kernel, NTHR, LDS_BYTES) != hipSuccess || per_cu < 1) { fprintf(stderr, "kernel_launch: occupancy query says %d\n", per_cu); }
        (void)hipGetLastError();
        grid = cus;
    }
    if (grid < 0) return;
    (void)hipMemsetAsync((char*)d_ws + WS_CTL, 0, CTL_ZERO_BYTES, stream);
    Args a{};
    a.x = (const float*)d_in[0]; a.mem = (const float*)d_in[1]; a.norm_g = (const float*)d_in[2]; a.w_in = (const float*)d_in[3]; a.ln_g = (const float*)d_in[4]; a.ln_b = (const float*)d_in[5];
    a.sp_w = (const float*)d_in[6]; a.sp_b = (const float*)d_in[7]; a.rel_bias = (const float*)d_in[8]; a.mem_norm_g = (const float*)d_in[9]; a.w_kv = (const float*)d_in[10];
    a.br_g = (const float*)d_in[11]; a.w_out = (const float*)d_in[12]; a.fin_g = (const float*)d_in[13];
    a.out = (float*)d_out; a.ws = (unsigned char*)d_ws;
#if MK_PER_PHASE
    for (int p = 0; p < N_PHASES; ++p) { a.ph_lo = p; a.ph_hi = p + 1; hipLaunchKernelGGL(fwd_kernel, dim3(grid), dim3(NTHR), LDS_BYTES, stream, a); }
#else
    a.ph_lo = 0; a.ph_hi = N_PHASES; hipLaunchKernelGGL(fwd_kernel, dim3(grid), dim3(NTHR), LDS_BYTES, stream, a);
#endif
}
```

```cpp
#include <hip/hip_runtime.h>
#include <cstdio>
#include <cstdint>

#define LAS __attribute__((address_space(3)))
#define GAS __attribute__((address_space(1)))
typedef _Float16 half_t;
typedef _Float16 h8 __attribute__((ext_vector_type(8)));
typedef _Float16 h4 __attribute__((ext_vector_type(4)));
typedef _Float16 h2 __attribute__((ext_vector_type(2)));
typedef float f32x2 __attribute__((ext_vector_type(2)));
typedef float f32x4 __attribute__((ext_vector_type(4)));
typedef float f32x16 __attribute__((ext_vector_type(16)));
typedef unsigned u32x2 __attribute__((ext_vector_type(2)));
typedef unsigned u32x4 __attribute__((ext_vector_type(4)));

constexpr int NB = 16, SEQ = 2048, DM = 1024, MTOK = NB * SEQ, MEML = 256, MMEM = NB * MEML;
constexpr int DIN = 3200, NP1 = 3328, NKV = 512, NB1 = NP1 + NKV;
constexpr int C_U = 0, C_V = 384, C_QB = 768, C_KB = 1152, C_VB = 1536, C_QM = 1920, C_Z = 2176;
constexpr int PP = DIN;
constexpr float EPS = 1e-6f;
constexpr int NWAVES = 8, NTHR = 512;

constexpr size_t MiB = 1u << 20;
constexpr size_t WS_CTL = 0, CTL_ZERO_BYTES = 256 * 1024;
constexpr size_t WS_SSX = 1 * MiB;
constexpr size_t WS_SSY = 2 * MiB;
constexpr size_t WS_KMEAN = 4 * MiB;
constexpr size_t WS_LUT = 4 * MiB + 512 * 1024;
constexpr size_t WS_WSP = 5 * MiB;
constexpr size_t WS_BT2 = 6 * MiB;
constexpr size_t WS_BT1 = 10 * MiB;
constexpr size_t WS_MKV = 26 * MiB;
constexpr size_t WS_XH = 34 * MiB;
constexpr size_t WS_Y = 106 * MiB;
constexpr size_t WS_PROJ = 170 * MiB;
constexpr size_t WS_END = 370 * MiB;
constexpr int CW_TMO = 0, CW_BAR = 4096, CW_QUEUE = 8192, CW_PANEL = 12288;

constexpr int RING_BYTES = 131072;
constexpr int AT_STG_ROW = 68;
constexpr int GM_VNT = 0, GM_VNT_ROW = 136, GM_VNT_BYTES = 64 * GM_VNT_ROW * 2;
constexpr int GM_STAGE = 36864;
constexpr int MISC_OFF = 155648;
constexpr int LDS_BYTES = MISC_OFF + 256;
static_assert(RING_BYTES + 2 * 768 * 4 <= MISC_OFF, "LDS map");

__device__ __forceinline__ unsigned pkh(float lo, float hi) { f32x2 v = {lo, hi}; h2 h = __builtin_convertvector(v, h2); return __builtin_bit_cast(unsigned, h); }
__device__ __forceinline__ float gelu_t(float x) { const float t = x * (1.0f + 0.044715f * x * x) * (2.0f * 0.7978845608028654f * 1.4426950408889634f); return x * __builtin_amdgcn_rcpf(1.0f + __builtin_amdgcn_exp2f(-t)); }
__device__ __forceinline__ float silu_f(float x) { return x * __builtin_amdgcn_rcpf(1.0f + __builtin_amdgcn_exp2f(-x * 1.4426950408889634f)); }
__device__ __forceinline__ f32x2 silu_pk(f32x2 v) { const f32x2 w = v * (-1.4426950408889634f); f32x2 e; e.x = __builtin_amdgcn_exp2f(w.x); e.y = __builtin_amdgcn_exp2f(w.y);
    const f32x2 d = e + 1.0f; f32x2 r; r.x = __builtin_amdgcn_rcpf(d.x); r.y = __builtin_amdgcn_rcpf(d.y); return v * r; }
__device__ __forceinline__ f32x2 gelu_pk(f32x2 v) { constexpr float k1 = 2.0f * 0.7978845608028654f * 1.4426950408889634f, k2 = 0.044715f;
    const f32x2 t = v * v, u = t * (-k1 * k2) + (-k1), w = v * u; f32x2 e; e.x = __builtin_amdgcn_exp2f(w.x); e.y = __builtin_amdgcn_exp2f(w.y);
    const f32x2 d = e + 1.0f; f32x2 r; r.x = __builtin_amdgcn_rcpf(d.x); r.y = __builtin_amdgcn_rcpf(d.y); return v * r; }
__device__ __forceinline__ float wave_sum(float v) {
#pragma unroll
    for (int o = 1; o < 64; o <<= 1) v += __shfl_xor(v, o);
    return v;
}
__device__ __forceinline__ int t5_bucket(int d) {
    if (d < 16) return d;
    return 16 + (d >= 19) + (d >= 21) + (d >= 24) + (d >= 27) + (d >= 31) + (d >= 35) + (d >= 40) + (d >= 46) + (d >= 52) + (d >= 59) + (d >= 67) + (d >= 77) + (d >= 87) + (d >= 99) + (d >= 113);
}

namespace pg8 {
constexpr unsigned XB_SPIN_CAP_ = 1u << 18;
constexpr int BM = 256, BK = 64, HALF = 128, HTB = HALF * BK * 2, STAGE_BYTES = 8 * HTB;
__host__ __device__ __forceinline__ int lds_byte(int r, int c) { const int st = (r >> 4) * 2 + (c >> 5), rr = r & 15, cc = c & 31, ob = rr * 64 + cc * 2; return st * 1024 + (ob ^ (((ob >> 9) & 1) << 5)); }
__host__ __device__ __forceinline__ void stage_rc(int b, int& R, int& C) { const int st = b / 1024, sb = b % 1024, swz = sb ^ (((sb >> 9) & 1) << 5); R = (st >> 1) * 16 + swz / 64; C = (st & 1) * 32 + (swz % 64) / 2; }
__host__ __device__ __forceinline__ int perm32(int rho) { const int n = rho >> 4, i = rho & 15; return 8 * (i >> 2) + 4 * n + (i & 3); }
struct Unit { int pm, pn; };
struct Gemm { const half_t* A; const half_t* Bt; int K; const float* ssy; };

template <class Epi, class Sched, bool KSCALE>
__device__ __forceinline__ void gemm_phase(LAS unsigned char* lds, const Gemm g, const Sched& S, const Epi& E) {
    int tid_ = threadIdx.x; asm volatile("" : "+v"(tid_));
    const int tid = tid_, wid = __builtin_amdgcn_readfirstlane(tid >> 6), lane = tid & 63, wr = wid >> 2, wc = wid & 3, fr = lane & 15, fq = lane >> 4;
    const int K = g.K, nt = K / BK;
    unsigned voffA[2], voffB[2];
#pragma unroll
    for (int i = 0; i < 2; ++i) { int R, C; stage_rc(tid * 16 + i * 8192, R, C); const int Rb = (R & ~31) + perm32(R & 31);
        voffA[i] = (unsigned)(R * K + C) * 2u; voffB[i] = (unsigned)(Rb * K + C) * 2u; }
    const size_t kstep = (size_t)(BK * 2);
    const size_t hstep = (size_t)HALF * K * 2;
    const size_t tstep = 2 * hstep;
    const unsigned ldsw = (unsigned)wid * 1024u;
    const int aoff = lds_byte(wr * 64 + fr, fq * 8), boff = lds_byte(wc * 32 + fr, fq * 8);
#define PG8_SA(b, h) (((b) * 2 + (h)) * HTB)
#define PG8_SB(b, h) ((4 + (b) * 2 + (h)) * HTB)
#define PG8_STAGE(bufoff, gbase, voff) do { _Pragma("unroll") for (int _i = 0; _i < 2; ++_i) \
        __builtin_amdgcn_global_load_lds((const unsigned*)((const char*)(gbase) + (voff)[_i]), (LAS unsigned*)(lds + (bufoff) + ldsw + _i * 8192), 16, 0, 0); } while (0)
#define PG8_LDA(dst, b, h) do { _Pragma("unroll") for (int m = 0; m < 4; ++m) _Pragma("unroll") for (int k = 0; k < 2; ++k) dst[m][k] = *(const LAS h8*)(lds + PG8_SA(b, h) + aoff + m * 2048 + k * 1024); } while (0)
#define PG8_LDB(dst, b, h) do { _Pragma("unroll") for (int n = 0; n < 2; ++n) _Pragma("unroll") for (int k = 0; k < 2; ++k) dst[n][k] = *(const LAS h8*)(lds + PG8_SB(b, h) + boff + n * 2048 + k * 1024); } while (0)
#define PG8_MMA(ai, bj, At, Bt) do { __builtin_amdgcn_s_setprio(1); _Pragma("unroll") for (int m = 0; m < 4; ++m) _Pragma("unroll") for (int n = 0; n < 2; ++n) _Pragma("unroll") for (int k = 0; k < 2; ++k) \
        acc[ai][bj][m][n] = __builtin_amdgcn_mfma_f32_16x16x32_f16(Bt[n][k], At[m][k], acc[ai][bj][m][n], 0, 0, 0); __builtin_amdgcn_s_setprio(0); } while (0)
#define PG8_WAIT_V(n) asm volatile("s_waitcnt vmcnt(" #n ")" ::: "memory")
#define PG8_WAIT_L(n) asm volatile("s_waitcnt lgkmcnt(" #n ")" ::: "memory")
#define PG8_BAR __builtin_amdgcn_s_barrier()
#define PG8_SCHED __builtin_amdgcn_sched_barrier(0)
    Unit cur, nxt; int ui = 0;
    if (!S.next(0, cur)) return;
    f32x4 acc[2][2][4][2];
#pragma unroll
    for (int a = 0; a < 2; ++a)
#pragma unroll
        for (int b = 0; b < 2; ++b)
#pragma unroll
            for (int m = 0; m < 4; ++m)
#pragma unroll
                for (int n = 0; n < 2; ++n) acc[a][b][m][n] = (f32x4){0.f, 0.f, 0.f, 0.f};
    h8 At[4][2], B0[2][2], B1[2][2];
    const char* cA = (const char*)g.A + (size_t)cur.pm * tstep; const char* cB = (const char*)g.Bt + (size_t)cur.pn * tstep;
    PG8_STAGE(PG8_SB(0, 0), cB, voffB); PG8_STAGE(PG8_SB(0, 1), cB + hstep, voffB); PG8_STAGE(PG8_SA(0, 0), cA, voffA); PG8_STAGE(PG8_SA(0, 1), cA + hstep, voffA);
    if (wr == 1) PG8_BAR;
    PG8_WAIT_V(2); PG8_BAR;
    PG8_STAGE(PG8_SB(1, 0), cB + kstep, voffB); PG8_STAGE(PG8_SA(1, 0), cA + kstep, voffA); PG8_STAGE(PG8_SB(1, 1), cB + hstep + kstep, voffB);
    PG8_WAIT_V(6); PG8_BAR;
    LAS float* ktab = (LAS float*)(lds + RING_BYTES);
    for (;;) {
        const bool has_next = S.next(ui + 1, nxt);
        if constexpr (KSCALE) {
            if (tid < 256) { const f32x4* sp = (const f32x4*)(g.ssy + (size_t)(cur.pm * BM + tid) * 16); const f32x4 s0 = sp[0], s1 = sp[1], s2 = sp[2], s3 = sp[3];
                const float sa = ((s0[0] + s0[1]) + (s0[2] + s0[3])) + (s1[0] + s1[1]), sb = ((s1[2] + s1[3]) + (s2[0] + s2[1])) + (s2[2] + s2[3]), sm = (s3[0] + s3[1]) + (s3[2] + s3[3]);
                const float va = sa * (1.0f / 384.0f) + EPS, vb = sb * (1.0f / 384.0f) + EPS, vm = sm * (1.0f / 256.0f) + EPS;
                LAS float* T = ktab + (ui & 1) * 768;
                T[tid] = sqrtf(vb / va); T[256 + tid] = sqrtf(vm / vb); T[512 + tid] = __builtin_amdgcn_rsqf(vm); }
        }
        const char* nA = has_next ? (const char*)g.A + (size_t)nxt.pm * tstep : cA; const char* nB = has_next ? (const char*)g.Bt + (size_t)nxt.pn * tstep : cB;
        for (int t = 0; t < nt; t += 2) {
            const bool last = (t == nt - 2);
            const char* a1 = cA + (size_t)(t + 1) * kstep;
            const char* a2 = last ? nA : cA + (size_t)(t + 2) * kstep; const char* b2 = last ? nB : cB + (size_t)(t + 2) * kstep;
            const char* a3 = a2 + kstep; const char* b3 = b2 + kstep;
            if constexpr (KSCALE) {
                if (t == 6 || t == 12) { const LAS float* T = ktab + (ui & 1) * 768 + (t == 12 ? 256 : 0);
#pragma unroll
                    for (int ai = 0; ai < 2; ++ai)
#pragma unroll
                        for (int m = 0; m < 4; ++m) { const float f = T[ai * HALF + wr * 64 + m * 16 + fr];
#pragma unroll
                            for (int bj = 0; bj < 2; ++bj)
#pragma unroll
                                for (int n = 0; n < 2; ++n) acc[ai][bj][m][n] *= f; } }
            }
            PG8_LDB(B0, 0, 0); PG8_LDB(B1, 0, 1); PG8_SCHED; PG8_LDA(At, 0, 0); PG8_STAGE(PG8_SA(1, 1), a1 + hstep, voffA);
            PG8_WAIT_V(8); PG8_WAIT_L(0); PG8_BAR; PG8_MMA(0, 0, At, B0); PG8_MMA(0, 1, At, B1); PG8_BAR; PG8_SCHED;
            PG8_LDA(At, 0, 1); PG8_STAGE(PG8_SB(0, 0), b2, voffB); PG8_STAGE(PG8_SB(0, 1), b2 + hstep, voffB); PG8_STAGE(PG8_SA(0, 0), a2, voffA);
            PG8_WAIT_V(8); PG8_WAIT_L(0); PG8_BAR; PG8_MMA(1, 0, At, B0); PG8_MMA(1, 1, At, B1); PG8_BAR; PG8_SCHED;
            PG8_LDB(B0, 1, 0); PG8_LDB(B1, 1, 1); PG8_SCHED; PG8_LDA(At, 1, 0); PG8_STAGE(PG8_SA(0, 1), a2 + hstep, voffA);
            PG8_WAIT_V(8); PG8_WAIT_L(0); PG8_BAR; PG8_MMA(0, 0, At, B0); PG8_MMA(0, 1, At, B1); PG8_BAR; PG8_SCHED;
            PG8_LDA(At, 1, 1); PG8_STAGE(PG8_SB(1, 0), b3, voffB); PG8_STAGE(PG8_SB(1, 1), b3 + hstep, voffB); PG8_STAGE(PG8_SA(1, 0), a3, voffA);
            PG8_WAIT_V(8); PG8_WAIT_L(0); PG8_BAR; PG8_MMA(1, 0, At, B0); PG8_MMA(1, 1, At, B1); PG8_BAR; PG8_SCHED;
        }
        if (wr == 0) PG8_BAR;
        E(acc, cur, wr, wc, fr, fq, ktab + (ui & 1) * 768 + 512);
        if (!has_next) break;
#pragma unroll
        for (int a = 0; a < 2; ++a)
#pragma unroll
            for (int b = 0; b < 2; ++b)
#pragma unroll
                for (int m = 0; m < 4; ++m)
#pragma unroll
                    for (int n = 0; n < 2; ++n) acc[a][b][m][n] = (f32x4){0.f, 0.f, 0.f, 0.f};
        cur = nxt; cA = nA; cB = nB; ++ui;
        if (wr == 1) PG8_BAR;
    }
    PG8_WAIT_V(0);
    PG8_BAR;
#undef PG8_SA
#undef PG8_SB
#undef PG8_STAGE
#undef PG8_LDA
#undef PG8_LDB
#undef PG8_MMA
#undef PG8_WAIT_V
#undef PG8_WAIT_L
#undef PG8_BAR
#undef PG8_SCHED
}

struct Order1 {
    int G, c;
    __device__ __forceinline__ bool next(int i, Unit& u) const {
        const int L = i * G + c, x = L % 8, off = L / 8;
        if (off < 208) { const int w = x * 208 + off; const int nig = 8 * 13, gid = w / nig, rem = w % nig; u.pm = gid * 8 + (rem % 8); u.pn = rem / 8; return true; }
        if (off < 212) { const int k = off - 208; u.pm = 128 + 2 * x + (k >> 1); u.pn = 13 + (k & 1); return true; }
        return false;
    }
};
struct Order2 {
    int G, c;
    __device__ __forceinline__ bool next(int i, Unit& u) const {
        const int L = i * G + c; constexpr int NW = 128 * 4;
        if (L >= NW) return false;
        const int q = NW / 8, xcd = L % 8, off = L / 8, w = xcd * q + off; const int nig = 8 * 4, gid = w / nig, rem = w % nig; u.pm = gid * 8 + (rem % 8); u.pn = rem / 8; return true;
    }
};

struct EpiProj {
    half_t* proj; half_t* mkv; const float* ssx; float* kmsum;
    __device__ __forceinline__ void operator()(const f32x4 (&acc)[2][2][4][2], const Unit& u, int wr, int wc, int fr, int fq, const LAS float*) const {
        if (u.pm >= 128) {
            const int row0 = (u.pm - 128) * BM + wr * 64 + fr, col0 = (u.pn - 13) * BM + wc * 32 + 8 * fq;
#pragma unroll
            for (int ai = 0; ai < 2; ++ai)
#pragma unroll
                for (int m = 0; m < 4; ++m) { half_t* rowp = mkv + (size_t)(row0 + ai * HALF + m * 16) * NKV + col0;
#pragma unroll
                    for (int bj = 0; bj < 2; ++bj) { const f32x4 v0 = acc[ai][bj][m][0], v1 = acc[ai][bj][m][1]; u32x4 w; w.x = pkh(v0[0], v0[1]); w.y = pkh(v0[2], v0[3]); w.z = pkh(v1[0], v1[1]); w.w = pkh(v1[2], v1[3]);
                        *(u32x4*)(rowp + bj * HALF) = w; } }
            return;
        }
        const int row0 = u.pm * BM + wr * 64 + fr;
        float rs[2][4];
#pragma unroll
        for (int ai = 0; ai < 2; ++ai)
#pragma unroll
            for (int m = 0; m < 4; ++m) rs[ai][m] = ssx[row0 + ai * HALF + m * 16];
#pragma unroll
        for (int ai = 0; ai < 2; ++ai)
#pragma unroll
            for (int m = 0; m < 4; ++m) rs[ai][m] = __builtin_amdgcn_rsqf(rs[ai][m] * (1.0f / DM) + EPS);
#pragma unroll
        for (int bj = 0; bj < 2; ++bj) {
            const int c128 = u.pn * 2 + bj;
            if (c128 >= 25) continue;
            const int col0 = c128 * HALF + wc * 32 + 8 * fq;
            if (c128 >= 9 && c128 < 12) {
                f32x4 c0 = (f32x4){0.f, 0.f, 0.f, 0.f}, c1 = c0;
#pragma unroll
                for (int ai = 0; ai < 2; ++ai)
#pragma unroll
                    for (int m = 0; m < 4; ++m) { c0 += acc[ai][bj][m][0] * rs[ai][m]; c1 += acc[ai][bj][m][1] * rs[ai][m]; }
#pragma unroll
                for (int e = 0; e < 4; ++e) {
#pragma unroll
                    for (int o = 1; o < 16; o <<= 1) { c0[e] += __shfl_xor(c0[e], o); c1[e] += __shfl_xor(c1[e], o); } }
                if (fr == 0) { float* kp = kmsum + (size_t)u.pm * 384 + (col0 - C_KB);
#pragma unroll
                    for (int e = 0; e < 4; ++e) { atomicAdd(kp + e, c0[e]); atomicAdd(kp + 4 + e, c1[e]); } }
            }
#pragma unroll
            for (int ai = 0; ai < 2; ++ai)
#pragma unroll
                for (int m = 0; m < 4; ++m) { const int row = row0 + ai * HALF + m * 16;
                    f32x4 v0 = acc[ai][bj][m][0] * rs[ai][m], v1 = acc[ai][bj][m][1] * rs[ai][m];
                    if (c128 >= 17) {
#pragma unroll
                        for (int e = 0; e < 4; e += 2) { const f32x2 a = silu_pk((f32x2){v0[e], v0[e + 1]}), b = silu_pk((f32x2){v1[e], v1[e + 1]}); v0[e] = a.x; v0[e + 1] = a.y; v1[e] = b.x; v1[e + 1] = b.y; } }
                    else if (c128 < 6) {
#pragma unroll
                        for (int e = 0; e < 4; e += 2) { const f32x2 a = gelu_pk((f32x2){v0[e], v0[e + 1]}), b = gelu_pk((f32x2){v1[e], v1[e + 1]}); v0[e] = a.x; v0[e + 1] = a.y; v1[e] = b.x; v1[e + 1] = b.y; } }
                    u32x4 w; w.x = pkh(v0[0], v0[1]); w.y = pkh(v0[2], v0[3]); w.z = pkh(v1[0], v1[1]); w.w = pkh(v1[2], v1[3]);
                    *(u32x4*)(proj + (size_t)row * PP + col0) = w; }
        }
    }
};
struct EpiResid {
    const half_t* resid16; half_t* xh; float* ssn;
    __device__ __forceinline__ void operator()(const f32x4 (&acc)[2][2][4][2], const Unit& u, int wr, int wc, int fr, int fq, const LAS float* T3) const {
        const int row0 = u.pm * BM + wr * 64 + fr, col0 = u.pn * BM + wc * 32 + 8 * fq;
#pragma unroll
        for (int ai = 0; ai < 2; ++ai) {
            h8 rh[4][2]; float f3[4];
#pragma unroll
            for (int m = 0; m < 4; ++m) { const size_t off = (size_t)(row0 + ai * HALF + m * 16) * DM + col0;
                rh[m][0] = *(const h8*)(resid16 + off); rh[m][1] = *(const h8*)(resid16 + off + HALF); f3[m] = T3[ai * HALF + wr * 64 + m * 16 + fr]; }
#pragma unroll
            for (int m = 0; m < 4; ++m) { const int row = row0 + ai * HALF + m * 16; const size_t off = (size_t)row * DM + col0; float s = 0.f; f32x2 s2 = {0.f, 0.f};
#pragma unroll
                for (int bj = 0; bj < 2; ++bj) { const h8 r = rh[m][bj];
                    const f32x4 v0 = acc[ai][bj][m][0] * f3[m] + (f32x4){(float)r[0], (float)r[1], (float)r[2], (float)r[3]}, v1 = acc[ai][bj][m][1] * f3[m] + (f32x4){(float)r[4], (float)r[5], (float)r[6], (float)r[7]};
                    u32x4 w; w.x = pkh(v0[0], v0[1]); w.y = pkh(v0[2], v0[3]); w.z = pkh(v1[0], v1[1]); w.w = pkh(v1[2], v1[3]);
                    *(u32x4*)(xh + off + bj * HALF) = w;
                    s2 = (f32x2){v0[0], v0[1]} * (f32x2){v0[0], v0[1]} + s2; s2 = (f32x2){v0[2], v0[3]} * (f32x2){v0[2], v0[3]} + s2;
                    s2 = (f32x2){v1[0], v1[1]} * (f32x2){v1[0], v1[1]} + s2; s2 = (f32x2){v1[2], v1[3]} * (f32x2){v1[2], v1[3]} + s2; }
                s = s2.x + s2.y;
                s += __shfl_xor(s, 16); s += __shfl_xor(s, 32);
                if (fq == 0) atomicAdd(ssn + row, s); }
            asm volatile("" ::: "memory");
        }
    }
};
struct EpiFinal {
    const half_t* resid16; float* out; float* ssn; const float* fin_g; unsigned* pcnt; unsigned* tmo;
    __device__ __forceinline__ void operator()(f32x4 (&acc)[2][2][4][2], const Unit& u, int wr, int wc, int fr, int fq, const LAS float* T3) const {
        const int row0 = u.pm * BM + wr * 64 + fr, col0 = u.pn * BM + wc * 32 + 8 * fq;
#pragma unroll
        for (int ai = 0; ai < 2; ++ai) {
            h8 rh[4][2]; float f3[4];
#pragma unroll
            for (int m = 0; m < 4; ++m) { const size_t off = (size_t)(row0 + ai * HALF + m * 16) * DM + col0;
                rh[m][0] = *(const h8*)(resid16 + off); rh[m][1] = *(const h8*)(resid16 + off + HALF); f3[m] = T3[ai * HALF + wr * 64 + m * 16 + fr]; }
#pragma unroll
            for (int m = 0; m < 4; ++m) { const int row = row0 + ai * HALF + m * 16; float s = 0.f; f32x2 s2 = {0.f, 0.f};
#pragma unroll
                for (int bj = 0; bj < 2; ++bj) { const h8 r = rh[m][bj];
                    const f32x4 v0 = acc[ai][bj][m][0] * f3[m] + (f32x4){(float)r[0], (float)r[1], (float)r[2], (float)r[3]}, v1 = acc[ai][bj][m][1] * f3[m] + (f32x4){(float)r[4], (float)r[5], (float)r[6], (float)r[7]};
                    acc[ai][bj][m][0] = v0; acc[ai][bj][m][1] = v1;
                    s2 = (f32x2){v0[0], v0[1]} * (f32x2){v0[0], v0[1]} + s2; s2 = (f32x2){v0[2], v0[3]} * (f32x2){v0[2], v0[3]} + s2;
                    s2 = (f32x2){v1[0], v1[1]} * (f32x2){v1[0], v1[1]} + s2; s2 = (f32x2){v1[2], v1[3]} * (f32x2){v1[2], v1[3]} + s2; }
                s = s2.x + s2.y;
                s += __shfl_xor(s, 16); s += __shfl_xor(s, 32);
                if (fq == 0) atomicAdd(ssn + row, s); }
        }
        asm volatile("s_waitcnt vmcnt(0)" ::: "memory");
        unsigned* cnt = pcnt + 64 * u.pm;
        if ((threadIdx.x & 63) == 0) (void)__hip_atomic_fetch_add(cnt, 1u, __ATOMIC_RELAXED, __HIP_MEMORY_SCOPE_AGENT);
        { unsigned sp = 0u;
          while ((unsigned)__builtin_amdgcn_readfirstlane((int)__hip_atomic_load(cnt, __ATOMIC_RELAXED, __HIP_MEMORY_SCOPE_AGENT)) < 32u) {
              __builtin_amdgcn_s_sleep(2);
              if ((++sp & 255u) == 0u) { if (__hip_atomic_load(tmo, __ATOMIC_RELAXED, __HIP_MEMORY_SCOPE_AGENT)) break; if (sp > XB_SPIN_CAP_) { atomicAdd(tmo, 1u); break; } } } }
        f32x4 g[2][2];
#pragma unroll
        for (int bj = 0; bj < 2; ++bj) { g[bj][0] = *(const f32x4*)(fin_g + col0 + bj * HALF); g[bj][1] = *(const f32x4*)(fin_g + col0 + bj * HALF + 4); }
#pragma unroll
        for (int ai = 0; ai < 2; ++ai) {
            float rs[4];
#pragma unroll
            for (int m = 0; m < 4; ++m) rs[m] = __hip_atomic_load(ssn + row0 + ai * HALF + m * 16, __ATOMIC_RELAXED, __HIP_MEMORY_SCOPE_AGENT);
#pragma unroll
            for (int m = 0; m < 4; ++m) { const float r = __builtin_amdgcn_rsqf(rs[m] * (1.0f / DM) + EPS); float* op = out + (size_t)(row0 + ai * HALF + m * 16) * DM + col0;
#pragma unroll
                for (int bj = 0; bj < 2; ++bj) { __builtin_nontemporal_store(acc[ai][bj][m][0] * r * g[bj][0], (f32x4*)(op + bj * HALF)); __builtin_nontemporal_store(acc[ai][bj][m][1] * r * g[bj][1], (f32x4*)(op + bj * HALF + 4)); } }
        }
    }
};
}

#define XB_TMO      128
#define XB_XCNT(j)  (256  + 64 * (j))
#define XB_XSUB(j)  (1280 + 64 * (j))
#define XB_XGEN(j)  (2304 + 64 * (j))
#define XB_TOP      3328
#define XB_TOPGEN   3392
#define XCD_BAR_WORDS 3456
#define XB_SPIN_CAP (1u << 18)
__device__ __forceinline__ unsigned xb_ld(unsigned* p)              { return __hip_atomic_load(p, __ATOMIC_RELAXED, __HIP_MEMORY_SCOPE_AGENT); }
__device__ __forceinline__ unsigned xb_add(unsigned* p, unsigned v) { return __hip_atomic_fetch_add(p, v, __ATOMIC_RELAXED, __HIP_MEMORY_SCOPE_AGENT); }
__device__ __forceinline__ unsigned xb_xcc_id() { return (unsigned)__builtin_amdgcn_s_getreg((3 << 11) | 20) & 0xFu; }
#define XB_SPIN(cond, bar) do { unsigned _sp = 0; while (cond) { __builtin_amdgcn_s_sleep(1); \
    if ((++_sp & 255u) == 0u) { if (xb_ld(&(bar)[XB_TMO])) break; if (_sp > XB_SPIN_CAP) { atomicAdd(&(bar)[XB_TMO], 1u); break; } } } } while (0)
struct XcdBarrier { unsigned* bar; unsigned x; volatile LAS unsigned* st; };
__device__ __forceinline__ XcdBarrier xcd_barrier_post(unsigned* bar, volatile LAS unsigned* st) {
    XcdBarrier b; b.bar = bar; b.x = xb_xcc_id(); b.st = st;
    if (threadIdx.x == 0) (void)xb_add(&bar[XB_XCNT(b.x)], 1u);
    return b;
}
__device__ __forceinline__ void xcd_barrier_complete(unsigned* bar, unsigned x, unsigned& nloc, unsigned& nx) {
    const unsigned G = gridDim.x * gridDim.y * gridDim.z;
    unsigned sum, cnt, mine, sp = 0u;
    for (;;) {
        sum = 0u; cnt = 0u; mine = 0u;
#pragma unroll
        for (unsigned j = 0; j < 16; ++j) { const unsigned c = xb_ld(&bar[XB_XCNT(j)]); sum += c; cnt += (c > 0u) ? 1u : 0u; mine = (j == x) ? c : mine; }
        if (sum == G) break;
        __builtin_amdgcn_s_sleep(1);
        if ((++sp & 255u) == 0u) { if (xb_ld(&bar[XB_TMO])) break; if (sp > XB_SPIN_CAP) { atomicAdd(&bar[XB_TMO], 1u); break; } }
    }
    nloc = mine > 0u ? mine : 1u; nx = cnt > 0u ? cnt : 1u;
}
__device__ __forceinline__ void xcd_barrier(const XcdBarrier& b) {
    asm volatile("s_waitcnt vmcnt(0)" ::: "memory");
    __syncthreads();
    if (threadIdx.x == 0) {
        unsigned* bar = b.bar;
        __builtin_amdgcn_s_waitcnt(0);
        unsigned nloc = b.st[0], nx = b.st[1];
        if (nloc == 0u) { xcd_barrier_complete(bar, b.x, nloc, nx); b.st[0] = nloc; b.st[1] = nx; }
        const unsigned old = xb_add(&bar[XB_XSUB(b.x)], 1u);
        const unsigned gen = old / nloc;
        if (old + 1u == (gen + 1u) * nloc) {
            __builtin_amdgcn_fence(__ATOMIC_RELEASE, "agent");
            asm volatile("s_waitcnt vmcnt(0)" ::: "memory");
            const unsigned og = xb_add(&bar[XB_TOP], 1u);
            const unsigned tg = og / nx;
            if (og + 1u == (tg + 1u) * nx) xb_add(&bar[XB_TOPGEN], 1u);
            else XB_SPIN(xb_ld(&bar[XB_TOPGEN]) == tg, bar);
            __builtin_amdgcn_fence(__ATOMIC_ACQUIRE, "agent");
            xb_add(&bar[XB_XGEN(b.x)], 1u);
            asm volatile("s_waitcnt vmcnt(0)" ::: "memory");
        } else {
            XB_SPIN(xb_ld(&bar[XB_XGEN(b.x)]) == gen, bar);
            __builtin_amdgcn_fence(__ATOMIC_ACQUIRE, "agent");
            asm volatile("s_waitcnt vmcnt(0)" ::: "memory");
        }
    }
    __syncthreads();
}

constexpr int GB_BASE = 32768;
#define GB_XCNT(g, x) (GB_BASE + ((g) * 16 + (x)) * 64)
#define GB_XSUB(g, x) (GB_BASE + 8192 + ((g) * 16 + (x)) * 64)
#define GB_XGEN(g, x) (GB_BASE + 16384 + ((g) * 16 + (x)) * 64)
#define GB_TOP(g)     (GB_BASE + 24576 + (g) * 64)
#define GB_TOPGEN(g)  (GB_BASE + 25088 + (g) * 64)
constexpr int GB_END = GB_BASE + 25600;
static_assert((size_t)GB_END * 4 <= CTL_ZERO_BYTES, "control words inside the zeroed region");
struct GrpBarrier { unsigned* ctl; unsigned g, x, gsize; volatile LAS unsigned* st; };
__device__ __forceinline__ GrpBarrier grp_barrier_post(unsigned* ctl, volatile LAS unsigned* st) {
    GrpBarrier b; b.ctl = ctl; b.g = blockIdx.x & 7u; b.x = xb_xcc_id(); b.gsize = (gridDim.x + 7u - b.g) / 8u; b.st = st;
    if (threadIdx.x == 0) (void)xb_add(&ctl[GB_XCNT(b.g, b.x)], 1u);
    return b;
}
__device__ __forceinline__ void grp_barrier_complete(const GrpBarrier& b, unsigned& nloc, unsigned& nx) {
    unsigned* tmo = b.ctl + CW_BAR;
    unsigned sum, cnt, mine, sp = 0u;
    for (;;) {
        sum = 0u; cnt = 0u; mine = 0u;
#pragma unroll
        for (unsigned j = 0; j < 16; ++j) { const unsigned c = xb_ld(&b.ctl[GB_XCNT(b.g, j)]); sum += c; cnt += (c > 0u) ? 1u : 0u; mine = (j == b.x) ? c : mine; }
        if (sum == b.gsize) break;
        __builtin_amdgcn_s_sleep(1);
        if ((++sp & 255u) == 0u) { if (xb_ld(&tmo[XB_TMO])) break; if (sp > XB_SPIN_CAP) { atomicAdd(&tmo[XB_TMO], 1u); break; } }
    }
    nloc = mine > 0u ? mine : 1u; nx = cnt > 0u ? cnt : 1u;
}
__device__ __forceinline__ void grp_barrier(const GrpBarrier& b) {
    asm volatile("s_waitcnt vmcnt(0)" ::: "memory");
    __syncthreads();
    if (threadIdx.x == 0) {
        unsigned* ctl = b.ctl; unsigned* tmo = ctl + CW_BAR;
        __builtin_amdgcn_s_waitcnt(0);
        unsigned nloc = b.st[0], nx = b.st[1];
        if (nloc == 0u) { grp_barrier_complete(b, nloc, nx); b.st[0] = nloc; b.st[1] = nx; }
        const unsigned old = xb_add(&ctl[GB_XSUB(b.g, b.x)], 1u);
        const unsigned gen = old / nloc;
        if (old + 1u == (gen + 1u) * nloc) {
            __builtin_amdgcn_fence(__ATOMIC_RELEASE, "agent");
            asm volatile("s_waitcnt vmcnt(0)" ::: "memory");
            const unsigned og = xb_add(&ctl[GB_TOP(b.g)], 1u);
            const unsigned tg = og / nx;
            if (og + 1u == (tg + 1u) * nx) xb_add(&ctl[GB_TOPGEN(b.g)], 1u);
            else XB_SPIN(xb_ld(&ctl[GB_TOPGEN(b.g)]) == tg, tmo);
            __builtin_amdgcn_fence(__ATOMIC_ACQUIRE, "agent");
            xb_add(&ctl[GB_XGEN(b.g, b.x)], 1u);
            asm volatile("s_waitcnt vmcnt(0)" ::: "memory");
        } else {
            XB_SPIN(xb_ld(&ctl[GB_XGEN(b.g, b.x)]) == gen, tmo);
            __builtin_amdgcn_fence(__ATOMIC_ACQUIRE, "agent");
            asm volatile("s_waitcnt vmcnt(0)" ::: "memory");
        }
    }
    __syncthreads();
}

struct Args {
    const float* x; const float* mem; const float* norm_g; const float* w_in; const float* ln_g; const float* ln_b; const float* sp_w; const float* sp_b;
    const float* rel_bias; const float* mem_norm_g; const float* w_kv; const float* br_g; const float* w_out; const float* fin_g;
    float* out; unsigned char* ws; int ph_lo, ph_hi;
};
struct Frame {
    LAS unsigned char* lds; int tid, lane, wave, G, bid;
    unsigned* ctl; float* ssx; float* ssy; float* kmean; half_t* wsp; half_t* bt2; half_t* bt1; half_t* mkv; half_t* xh; half_t* y; half_t* proj;
};
typedef const Args __attribute__((address_space(4))) * KArgs;
__device__ __forceinline__ KArgs kargs() { unsigned long long v = (unsigned long long)__builtin_amdgcn_kernarg_segment_ptr(); asm volatile("" : "+s"(v)); return (KArgs)v; }
__device__ __forceinline__ Args load_args() {
    KArgs p = kargs(); Args a;
    a.x = p->x; a.mem = p->mem; a.norm_g = p->norm_g; a.w_in = p->w_in; a.ln_g = p->ln_g; a.ln_b = p->ln_b; a.sp_w = p->sp_w; a.sp_b = p->sp_b;
    a.rel_bias = p->rel_bias; a.mem_norm_g = p->mem_norm_g; a.w_kv = p->w_kv; a.br_g = p->br_g; a.w_out = p->w_out; a.fin_g = p->fin_g;
    a.out = p->out; a.ws = p->ws; a.ph_lo = p->ph_lo; a.ph_hi = p->ph_hi;
    return a;
}
__device__ __forceinline__ Frame make_frame(LAS unsigned char* lds, const Args& a) {
    Frame F; F.lds = lds;
    int t = threadIdx.x; asm volatile("" : "+v"(t));
    F.tid = t; F.lane = t & 63; F.wave = __builtin_amdgcn_readfirstlane(t >> 6); F.G = gridDim.x; F.bid = blockIdx.x;
    unsigned char* ws = a.ws;
    F.ctl = (unsigned*)(ws + WS_CTL); F.ssx = (float*)(ws + WS_SSX); F.ssy = (float*)(ws + WS_SSY); F.kmean = (float*)(ws + WS_KMEAN);
    F.wsp = (half_t*)(ws + WS_WSP); F.bt2 = (half_t*)(ws + WS_BT2); F.bt1 = (half_t*)(ws + WS_BT1); F.mkv = (half_t*)(ws + WS_MKV);
    F.xh = (half_t*)(ws + WS_XH); F.y = (half_t*)(ws + WS_Y); F.proj = (half_t*)(ws + WS_PROJ);
    return F;
}

__device__ __forceinline__ void p0_transpose_item(const float* W, int K, int N, half_t* WT, int row_off, const float* gk, bool qscale, LAS float* scr, int item, int lane) {
    const int nblk = N / 32, kb = item / nblk, nb = item % nblk, k0 = 64 * kb, n0 = 32 * nb;
#pragma unroll 8
    for (int i = 0; i < 32; ++i) { const int kk = 2 * i + (lane >> 5); scr[kk * 33 + (lane & 31)] = __builtin_nontemporal_load(W + (size_t)(k0 + kk) * N + n0 + (lane & 31)) * gk[k0 + kk]; }
    asm volatile("s_waitcnt lgkmcnt(0)" ::: "memory");
    const int c = lane & 7;
#pragma unroll
    for (int j = 0; j < 4; ++j) { const int n = (lane >> 3) + 8 * j; const LAS float* s = scr + (8 * c) * 33 + n;
        const int ng = n0 + n; const float sc = (qscale && ((ng >= C_QB && ng < C_KB) || (ng >= C_QM && ng < C_Z))) ? 0.125f * 1.4426950408889634f : 1.0f;
        u32x4 o; o.x = pkh(s[0 * 33] * sc, s[1 * 33] * sc); o.y = pkh(s[2 * 33] * sc, s[3 * 33] * sc); o.z = pkh(s[4 * 33] * sc, s[5 * 33] * sc); o.w = pkh(s[6 * 33] * sc, s[7 * 33] * sc);
        *(u32x4*)(WT + (size_t)(row_off + n0 + n) * K + k0 + 8 * c) = o; }
    asm volatile("s_waitcnt lgkmcnt(0)" ::: "memory");
}
__device__ __forceinline__ float row_to_half(const float* xrow, half_t* orow, bool normalise, int lane) {
    const f32x4* xr = (const f32x4*)xrow + lane;
    f32x4 v[4]; float s = 0.f;
#pragma unroll
    for (int j = 0; j < 4; ++j) { v[j] = xr[64 * j]; s += (v[j].x * v[j].x + v[j].y * v[j].y) + (v[j].z * v[j].z + v[j].w * v[j].w); }
    s = wave_sum(s);
    const float sc = normalise ? __builtin_amdgcn_rsqf(s * (1.0f / DM) + EPS) : 1.0f;
    u32x2* o8 = (u32x2*)orow + lane;
#pragma unroll
    for (int j = 0; j < 4; ++j) { u32x2 w; w.x = pkh(v[j].x * sc, v[j].y * sc); w.y = pkh(v[j].z * sc, v[j].w * sc); o8[64 * j] = w; }
    return s;
}
__device__ __forceinline__ void p0_weights(Frame& F, const Args& a) {
    LAS float* scr = (LAS float*)(F.lds + F.wave * 16384);
    const int gw = F.bid * NWAVES + F.wave, NGW = F.G * NWAVES;
    constexpr int I_IN = (DM / 64) * (DIN / 32), I_KV = (DM / 64) * (NKV / 32), I_OUT = (DM / 64) * (DM / 32);
    constexpr int PER_L = I_IN + I_KV + I_OUT;
    for (int it = gw; it < 2 * PER_L; it += NGW) {
        const int l = it / PER_L; int r = it % PER_L;
        if (r < I_IN) { p0_transpose_item(a.w_in + (size_t)l * DM * DIN, DM, DIN, F.bt1 + (size_t)l * NB1 * DM, 0, a.norm_g + l * DM, true, scr, r, F.lane); continue; } r -= I_IN;
        if (r < I_KV) { p0_transpose_item(a.w_kv + (size_t)l * DM * NKV, DM, NKV, F.bt1 + (size_t)l * NB1 * DM, NP1, a.mem_norm_g + l * DM, false, scr, r, F.lane); continue; } r -= I_KV;
        p0_transpose_item(a.w_out + (size_t)l * DM * DM, DM, DM, F.bt2 + (size_t)l * DM * DM, 0, a.br_g + l * DM, false, scr, r, F.lane);
    }
}
__device__ __forceinline__ void p0_rows(Frame& F, const Args& a) {
    const int gw = F.bid * NWAVES + F.wave, NGW = F.G * NWAVES;
    for (int m0 = gw * 4; m0 < MTOK + MMEM; m0 += NGW * 4) {
        const bool isx = m0 < MTOK; const float* src = isx ? a.x + (size_t)m0 * DM : a.mem + (size_t)(m0 - MTOK) * DM;
        f32x4 v[4][4];
#pragma unroll
        for (int i = 0; i < 4; ++i) { const f32x4* xr = (const f32x4*)(src + (size_t)i * DM) + 2 * F.lane;
#pragma unroll
            for (int j = 0; j < 2; ++j) { v[i][2 * j] = __builtin_nontemporal_load(xr + 128 * j); v[i][2 * j + 1] = __builtin_nontemporal_load(xr + 128 * j + 1); } }
#pragma unroll
        for (int i = 0; i < 4; ++i) { float s = 0.f;
#pragma unroll
            for (int j = 0; j < 4; ++j) s += (v[i][j].x * v[i][j].x + v[i][j].y * v[i][j].y) + (v[i][j].z * v[i][j].z + v[i][j].w * v[i][j].w);
            s = wave_sum(s);
            const float sc = isx ? 1.0f : __builtin_amdgcn_rsqf(s * (1.0f / DM) + EPS);
            u32x4* o16 = (u32x4*)(F.xh + (size_t)(m0 + i) * DM) + F.lane;
#pragma unroll
            for (int j = 0; j < 2; ++j) { u32x4 w; w.x = pkh(v[i][2 * j].x * sc, v[i][2 * j].y * sc); w.y = pkh(v[i][2 * j].z * sc, v[i][2 * j].w * sc);
                w.z = pkh(v[i][2 * j + 1].x * sc, v[i][2 * j + 1].y * sc); w.w = pkh(v[i][2 * j + 1].z * sc, v[i][2 * j + 1].w * sc); o16[64 * j] = w; }
            if (isx && F.lane == 0) F.ssx[m0 + i] = s; }
    }
}
__device__ __forceinline__ void p0_prologue(Frame& F, const Args& a) {
    if (F.wave & 1) { p0_rows(F, a); p0_weights(F, a); } else { p0_weights(F, a); p0_rows(F, a); }
    const int gt = F.bid * NTHR + F.tid, NGT = F.G * NTHR;
    for (int i = gt; i < 2 * 128 * DM / 8; i += NGT) { const int l = i / (128 * DM / 8), r = i % (128 * DM / 8); *(u32x4*)(F.bt1 + (size_t)l * NB1 * DM + (size_t)DIN * DM + (size_t)r * 8) = (u32x4){0u, 0u, 0u, 0u}; }
    for (int i = gt; i < 2 * 6 * 128 * 128; i += NGT) { const int s = i & 127, t = (i >> 7) & 127; F.wsp[i] = (half_t)(s <= t ? a.sp_w[i] : 0.0f); }
    for (int i = gt; i < 2 * MTOK; i += NGT) F.ssx[MTOK + i] = 0.f;
    for (int i = gt; i < 2 * 128 * 384; i += NGT) F.kmean[i] = 0.f;
    for (int i = gt; i < 6 * 768; i += NGT) { const int h = i / 768, d = 511 - (i % 768); ((float*)(a.ws + WS_LUT))[i] = d < 0 ? -INFINITY : a.rel_bias[t5_bucket(d > 127 ? 127 : d) * 6 + h] * 1.4426950408889634f; }
}

namespace fa {
typedef short s16x4 __attribute__((ext_vector_type(4)));
typedef short s16x8 __attribute__((ext_vector_type(8)));
typedef short v4i16_t __attribute__((ext_vector_type(4)));
typedef LAS const unsigned char* lds_cptr;
constexpr int NSLOT = 4, NSLOTV = 4, SLOTB = 8192, KVBLK = 64;
constexpr int LDS_K = 0, LDS_V = NSLOT * SLOTB, LDS_WS = (NSLOT + NSLOTV) * SLOTB, LDS_STG = LDS_WS + 2048, STG_ROW = 68, STG_W = 32 * STG_ROW * 4, LDS_LUT = LDS_STG + 8 * STG_W, LUT_N = 768, LDS_END = LDS_LUT + 6 * LUT_N * 4;
#define SBAR() __builtin_amdgcn_sched_barrier(0)
__device__ __forceinline__ int crow(int r, int hi) { return (r & 3) + 8 * (r >> 2) + 4 * hi; }
__device__ __forceinline__ void glds16(const void* gsrc, unsigned lds_dst) { unsigned keep;
    asm volatile("s_mov_b32 %0, m0\n\ts_mov_b32 m0, %2\n\ts_nop 0\n\tglobal_load_lds_dwordx4 %1, off\n\ts_mov_b32 m0, %0" : "=&s"(keep) : "v"(gsrc), "s"(lds_dst) : "memory"); }
__device__ __forceinline__ float max3f(float a, float b, float c) { float r; asm("v_max3_f32 %0, %1, %2, %3" : "=v"(r) : "v"(a), "v"(b), "v"(c)); return r; }
__device__ __forceinline__ float max2f(float a, float b) { float r; asm("v_max_f32_e32 %0, %1, %2" : "=v"(r) : "v"(a), "v"(b)); return r; }
__device__ __forceinline__ float fadd_s(float a, float b) { float r; asm("v_add_f32_e32 %0, %1, %2" : "=v"(r) : "v"(a), "v"(b)); return r; }
__device__ __forceinline__ float fsub_s(float a, float b) { float r; asm("v_sub_f32_e32 %0, %1, %2" : "=v"(r) : "v"(a), "v"(b)); return r; }
#define WAIT_BAR(N) asm volatile("s_waitcnt vmcnt(" #N ") lgkmcnt(0)\n\ts_barrier" ::: "memory")
__device__ __forceinline__ void qkt(f32x16& p0, f32x16& p1, lds_cptr Kslot, const h8* qr, const f32x16& negm, int r32, int hi) {
    lds_cptr kb = Kslot + hi * 1024 + r32 * 16;
#pragma unroll
    for (int d0 = 0; d0 < 4; ++d0) {
        const h8 b0 = *(const LAS h8*)(kb + d0 * 2048);
        const h8 b1 = *(const LAS h8*)(kb + d0 * 2048 + 512);
        if (d0 == 0) { p0 = __builtin_amdgcn_mfma_f32_32x32x16_f16(b0, qr[0], negm, 0, 0, 0); p1 = __builtin_amdgcn_mfma_f32_32x32x16_f16(b1, qr[0], negm, 0, 0, 0); }
        else { p0 = __builtin_amdgcn_mfma_f32_32x32x16_f16(b0, qr[d0], p0, 0, 0, 0); p1 = __builtin_amdgcn_mfma_f32_32x32x16_f16(b1, qr[d0], p1, 0, 0, 0); } }
}
__device__ __forceinline__ void kload8(h8* kf, lds_cptr kp) {
    kf[0] = *(const LAS h8*)(kp);        kf[1] = *(const LAS h8*)(kp + 512);
    kf[2] = *(const LAS h8*)(kp + 2048); kf[3] = *(const LAS h8*)(kp + 2560);
    kf[4] = *(const LAS h8*)(kp + 4096); kf[5] = *(const LAS h8*)(kp + 4608);
    kf[6] = *(const LAS h8*)(kp + 6144); kf[7] = *(const LAS h8*)(kp + 6656);
}
__device__ __forceinline__ void kload2(h8* kf, lds_cptr kp, int j) { kf[2 * j] = *(const LAS h8*)(kp + j * 2048); kf[2 * j + 1] = *(const LAS h8*)(kp + j * 2048 + 512); }
__device__ __forceinline__ s16x4 vtr(lds_cptr p) { return __builtin_bit_cast(s16x4, __builtin_amdgcn_ds_read_tr16_b64_v4i16((LAS v4i16_t*)p)); }
__device__ __forceinline__ float rowmax(const f32x16& p0, const f32x16& p1) {
    float a = max3f(p0[0], p0[1], p1[0]), b = max3f(p0[2], p0[3], p1[1]); a = max3f(a, p1[2], p1[3]);
#pragma unroll
    for (int r = 4; r < 16; r += 4) { a = max3f(a, p0[r], p0[r + 1]); b = max3f(b, p0[r + 2], p0[r + 3]); a = max3f(a, p1[r], p1[r + 1]); b = max3f(b, p1[r + 2], p1[r + 3]); }
    const float m = max2f(a, b);
    auto rr = __builtin_amdgcn_permlane32_swap(__float_as_uint(m), __float_as_uint(m), false, false);
    return max2f(__uint_as_float(rr[0]), __uint_as_float(rr[1]));
}
__device__ __forceinline__ void pv(f32x16* o, int vb, h8 pa0, h8 pa1, h8 pa2, h8 pa3) {
#pragma unroll
    for (int d0 = 0; d0 < 2; ++d0) { s16x4 lo[4], hi[4];
#pragma unroll
        for (int ks = 0; ks < 4; ++ks) {
            asm volatile("ds_read_b64_tr_b16 %0,%1 offset:%c2" : "=&v"(lo[ks]) : "v"(vb), "i"(d0 * 4096 + ks * 1024) : "memory");
            asm volatile("ds_read_b64_tr_b16 %0,%1 offset:%c2" : "=&v"(hi[ks]) : "v"(vb), "i"(d0 * 4096 + ks * 1024 + 512) : "memory"); }
        asm volatile("s_waitcnt lgkmcnt(0)" ::: "memory"); SBAR();
#define FA_PK(k) __builtin_bit_cast(h8, (s16x8){lo[k][0], lo[k][1], lo[k][2], lo[k][3], hi[k][0], hi[k][1], hi[k][2], hi[k][3]})
        o[d0] = __builtin_amdgcn_mfma_f32_32x32x16_f16(pa0, FA_PK(0), o[d0], 0, 0, 0);
        o[d0] = __builtin_amdgcn_mfma_f32_32x32x16_f16(pa1, FA_PK(1), o[d0], 0, 0, 0);
        o[d0] = __builtin_amdgcn_mfma_f32_32x32x16_f16(pa2, FA_PK(2), o[d0], 0, 0, 0);
        o[d0] = __builtin_amdgcn_mfma_f32_32x32x16_f16(pa3, FA_PK(3), o[d0], 0, 0, 0);
#undef FA_PK
    }
}
__device__ __forceinline__ void table_mask(f32x16& p0, f32x16& p1, const LAS float* base) {
#pragma unroll
    for (int g = 0; g < 4; ++g) {
#pragma unroll
        for (int e = 0; e < 4; ++e) { const int r = 4 * g + e; p0[r] += base[e + 8 * g]; p1[r] += base[32 + e + 8 * g]; }

    }
}
__device__ __forceinline__ void past_mask_far(f32x16& p0, f32x16& p1, int t, unsigned selmask, float c31) {
    const float cin = ((selmask >> (t >> 2)) & 1u) != 0u ? c31 : -INFINITY;
#pragma unroll
    for (int r = 0; r < 16; ++r) { p0[r] += cin; p1[r] += cin; }
}
__device__ __forceinline__ void past_mask(f32x16& p0, f32x16& p1, int t, int qt, int wid, int r32, int hi, unsigned selmask, float c31, const LAS float* lutE) {
    const int j = t >> 2, ti = t & 3;
    if (j == qt - 1 && 32 * wid + 193 - 64 * ti < 113) {
        const bool sel = ((selmask >> j) & 1u) != 0u;
        const int dbase = 256 + wid * 32 + r32 - 64 * ti - 4 * hi;
        table_mask(p0, p1, sel ? lutE + (511 - dbase) : lutE + 512);
    } else past_mask_far(p0, p1, t, selmask, c31);
}
__device__ __forceinline__ void band_mask(f32x16& p0, f32x16& p1, int jb, int qrel, int hi, const LAS float* lutE) { table_mask(p0, p1, lutE + (511 - (qrel - 64 * jb - 4 * hi))); }

template <bool MOBA, int THRL>
__device__ __forceinline__ void attn_unit(LAS unsigned char* shm, const half_t* Qu, int QP, const half_t* Kh, const half_t* Vh, int KP, int NT, int qt,
                                          const float* km, const LAS float* lutw, half_t* Yg, const half_t* Zg, float* ssyp,
                                          h8 (&qr)[4], bool qpre, bool resident, const half_t* nextQ, int nextQP) {
    int tid_ = threadIdx.x; asm volatile("" : "+v"(tid_));
    const int tid = tid_, lane = tid & 63, r32 = lane & 31, hi = lane >> 5; const int wid = __builtin_amdgcn_readfirstlane(tid >> 6);
    const half_t* Qw = Qu + (size_t)(wid * 32) * QP;
    const unsigned lds0 = (unsigned)(uintptr_t)shm;
    LAS float* wsf = (LAS float*)(shm + LDS_WS) + wid * 64;
    const half_t* ksrc = Kh + (size_t)lane * KP + wid * 8;
    const half_t* vsrc = Vh + (size_t)(16 * (wid & 3) + (lane >> 2)) * KP + (wid >> 2) * 32 + (lane & 3) * 8;
    const unsigned kdst = lds0 + LDS_K + wid * 1024, vdst = lds0 + LDS_V + wid * 1024;
#define DMA_K(t, slot) glds16(ksrc + (size_t)(t) * KVBLK * KP, (unsigned)__builtin_amdgcn_readfirstlane(kdst + (slot)))
#define DMA_V(t, slot) glds16(vsrc + (size_t)(t) * KVBLK * KP, (unsigned)__builtin_amdgcn_readfirstlane(vdst + (slot)))
    const int vb0 = (int)(lds0 + LDS_V) + ((lane >> 4) & 1) * 32 + (lane & 3) * 8 + (4 * hi + ((lane & 15) >> 2)) * 64;
    const lds_cptr Kbase = shm + LDS_K; h8 kf[8];
    const lds_cptr kp0 = shm + LDS_K + hi * 1024 + r32 * 16; const lds_cptr vp0 = shm + LDS_V + ((lane >> 4) & 1) * 32 + (lane & 3) * 8 + (4 * hi + ((lane & 15) >> 2)) * 64;
    if (!resident) { DMA_K(0, 0); DMA_V(0, 0); DMA_K(1, SLOTB); }
    if (!qpre) {
#pragma unroll
        for (int d0 = 0; d0 < 4; ++d0) qr[d0] = *(const h8*)(Qw + (size_t)r32 * QP + d0 * 16 + hi * 8);
    }
    unsigned selmask = 0u; float c31 = 0.f;
    if (MOBA) {
        c31 = lutw[511 - 127];
        float gs[8];
        if (qt > 0) {
            f32x16 gacc = f32x16{};
#pragma unroll
            for (int d0 = 0; d0 < 4; ++d0) { h8 ka = h8{};
                if (r32 < qt) { const float* kp = km + r32 * 384 + d0 * 16 + hi * 8; const f32x4 k0 = *(const f32x4*)kp, k1 = *(const f32x4*)(kp + 4);
                    u32x4 w; w.x = pkh(k0[0] * (1.0f / 256.0f), k0[1] * (1.0f / 256.0f)); w.y = pkh(k0[2] * (1.0f / 256.0f), k0[3] * (1.0f / 256.0f));
                    w.z = pkh(k1[0] * (1.0f / 256.0f), k1[1] * (1.0f / 256.0f)); w.w = pkh(k1[2] * (1.0f / 256.0f), k1[3] * (1.0f / 256.0f)); ka = __builtin_bit_cast(h8, w); }
                gacc = __builtin_amdgcn_mfma_f32_32x32x16_f16(ka, qr[d0], gacc, 0, 0, 0); }
#pragma unroll
            for (int i = 0; i < 4; ++i) { auto rr = __builtin_amdgcn_permlane32_swap(__float_as_uint(gacc[i]), __float_as_uint(gacc[i]), false, false);
                const float own = gacc[i], oth = hi == 0 ? __uint_as_float(rr[1]) : __uint_as_float(rr[0]);
                gs[i] = hi == 0 ? own : oth; gs[4 + i] = hi == 0 ? oth : own; }
        } else {
#pragma unroll
            for (int j = 0; j < 8; ++j) gs[j] = 0.f;
        }
#pragma unroll
        for (int j = 0; j < 7; ++j) if (j >= qt) gs[j] = -INFINITY;
#pragma unroll
        for (int j = 0; j < 7; ++j) { int cnt = 0;
#pragma unroll
            for (int k = 0; k < 7; ++k) if (k != j) cnt += (k < j ? gs[k] >= gs[j] : gs[k] > gs[j]) ? 1 : 0;
            if (j < qt && cnt < 3) selmask |= 1u << j; }
    }
    float mhat = 0.f, l_reg = 0.f; f32x16 o[2]; o[0] = f32x16{}; o[1] = f32x16{}; f32x16 negm = f32x16{}; asm volatile("" : "+v"(negm));
    const int qrel = wid * 32 + r32;
#define CMASK(P0, P1, t) do { if (MOBA) { const int jb_ = (t) - (NT - 4); if (jb_ >= 0) band_mask(P0, P1, jb_, qrel, hi, lutw); else past_mask(P0, P1, (t), qt, wid, r32, hi, selmask, c31, lutw); } } while (0)
    bool resc = false;
#define START(P0, P1) do { const float rm = max2f(rowmax(P0, P1), -1000.0f); resc = false; \
    { const float dl = rm; mhat = fadd_s(mhat, dl); \
      _Pragma("unroll") for (int r = 0; r < 16; ++r) { P0[r] = fsub_s(P0[r], dl); P1[r] = fsub_s(P1[r], dl); } \
      _Pragma("unroll") for (int r = 0; r < 16; ++r) negm[r] = -mhat; asm volatile("" : "+v"(negm)); } \
    _Pragma("unroll") for (int r = 0; r < 16; ++r) P0[r] = __builtin_amdgcn_exp2f(P0[r]); } while (0)
#define RESC() do { if (resc) { asm volatile("s_waitcnt lgkmcnt(0)" ::: "memory"); \
      _Pragma("unroll") for (int d_ = 0; d_ < 2; ++d_) _Pragma("unroll") for (int r = 0; r < 16; ++r) o[d_][r] *= wsf[crow(r, hi)]; } } while (0)
    f32x16 pA0, pA1, pB0, pB1;
#define ROT() do { } while (0)
    if (!resident) DMA_K(2, 2 * SLOTB);
    WAIT_BAR(3);
    qkt(pA0, pA1, Kbase, qr, negm, r32, hi); asm volatile("s_nop 15\n\ts_nop 7" : "+v"(pA0), "+v"(pA1)); CMASK(pA0, pA1, 0);
    START(pA0, pA1);
    _Pragma("unroll") for (int r = 0; r < 16; ++r) pA1[r] = __builtin_amdgcn_exp2f(pA1[r]);
    WAIT_BAR(0);
    if (!resident) { DMA_K(3, 3 * SLOTB); DMA_V(1, SLOTB); DMA_V(2, 2 * SLOTB); }
    kload8(kf, kp0 + SLOTB);
    WAIT_BAR(3);
    s16x4 vlo[8], vhi[8]; u32x4 pw0, pw1, pw2, pw3;
#define PKW(P, B) pkh(P[B], P[B + 1])
#define PAF(k) __builtin_bit_cast(h8, pw##k)
#define VFR(i) __builtin_bit_cast(h8, (s16x8){vlo[i][0], vlo[i][1], vlo[i][2], vlo[i][3], vhi[i][0], vhi[i][1], vhi[i][2], vhi[i][3]})
#define PIN(x) asm volatile("" : "+v"(x))
#define MX3(a, b, c) __builtin_fmaxf(__builtin_fmaxf((a), (b)), (c))
#define GAPA(MF, A0, A1, A2, A3, W0, W1, PW) do { MF; sacc += A0; sacc += A1; sacc += A2; sacc += A3; PIN(sacc); W0; W1; PIN(PW); SBAR(); } while (0)
#define EX(v) __builtin_amdgcn_exp2f(v)
#define GAPB(MF, X, B) do { MF; X[B] = EX(X[B]); X[B + 1] = EX(X[B + 1]); X[B + 2] = EX(X[B + 2]); X[B + 3] = EX(X[B + 3]); PIN(X); SBAR(); } while (0)
#define VRD(i) do { vlo[i] = vtr(vp_ + (((i) >> 2) * 4096 + ((i) & 3) * 1024)); vhi[i] = vtr(vp_ + (((i) >> 2) * 4096 + ((i) & 3) * 1024 + 512)); } while (0)
#define KRD(G, j, t) do { if (G) { kload2(kf, kp0 + ((((t) + 1) & 3) * SLOTB), j); SBAR(); } } while (0)
#define MF16 __builtin_amdgcn_mfma_f32_32x32x16_f16
#define STEP(C0, C1, P0, P1, t, GK, GV, GL) do { SBAR(); \
    const lds_cptr vp_ = vp0 + ((((t) - 1) & 3) * SLOTB); \
    VRD(0); SBAR(); float sacc = (P0[0] + P0[1]); \
    GAPA(C0 = MF16(kf[0], qr[0], negm, 0, 0, 0), P0[2], P0[3], P0[4], P0[5],     pw0[0] = PKW(P0, 0), pw0[1] = PKW(P0, 2), pw0); \
    VRD(4); SBAR(); GAPA(C1 = MF16(kf[1], qr[0], negm, 0, 0, 0), P0[6], P0[7], P0[8], P0[9],     pw0[2] = PKW(P0, 4), pw0[3] = PKW(P0, 6), pw0); \
    VRD(1); SBAR(); GAPA(C0 = MF16(kf[2], qr[1], C0, 0, 0, 0),   P0[10], P0[11], P0[12], P0[13], pw1[0] = PKW(P0, 8), pw1[1] = PKW(P0, 10), pw1); \
    VRD(5); SBAR(); GAPA(C1 = MF16(kf[3], qr[1], C1, 0, 0, 0),   P0[14], P0[15], P1[0], P1[1],   pw1[2] = PKW(P0, 12), pw1[3] = PKW(P0, 14), pw1); \
    VRD(2); SBAR(); GAPA(C0 = MF16(kf[4], qr[2], C0, 0, 0, 0),   P1[2], P1[3], P1[4], P1[5],     pw2[0] = PKW(P1, 0), pw2[1] = PKW(P1, 2), pw2); \
    VRD(6); SBAR(); GAPA(C1 = MF16(kf[5], qr[2], C1, 0, 0, 0),   P1[6], P1[7], P1[8], P1[9],     pw2[2] = PKW(P1, 4), pw2[3] = PKW(P1, 6), pw2); \
    VRD(3); SBAR(); GAPA(C0 = MF16(kf[6], qr[3], C0, 0, 0, 0),   P1[10], P1[11], P1[12], P1[13], pw3[0] = PKW(P1, 8), pw3[1] = PKW(P1, 10), pw3); \
    VRD(7); SBAR(); GAPA(C1 = MF16(kf[7], qr[3], C1, 0, 0, 0),   P1[14], P1[15], 0.f, 0.f,       pw3[2] = PKW(P1, 12), pw3[3] = PKW(P1, 14), pw3); \
    l_reg += sacc; \
    if ((GK) && !resident) { DMA_K((t) + 3, (((t) + 3) & 3) * SLOTB); } if ((GV) && !resident) { DMA_V((t) + 2, (((t) + 2) & 3) * SLOTB); } \
    CMASK(C0, C1, t); \
    { float a = MX3(C0[0], C0[1], C1[0]), b = MX3(C0[2], C0[3], C1[1]); a = MX3(a, C1[2], C1[3]); \
      _Pragma("unroll") for (int r = 4; r < 16; r += 4) { a = MX3(a, C0[r], C0[r + 1]); b = MX3(b, C0[r + 2], C0[r + 3]); a = MX3(a, C1[r], C1[r + 1]); b = MX3(b, C1[r + 2], C1[r + 3]); } \
      float rm = __builtin_fmaxf(a, b); { auto rr = __builtin_amdgcn_permlane32_swap(__float_as_uint(rm), __float_as_uint(rm), false, false); rm = __builtin_fmaxf(__uint_as_float(rr[0]), __uint_as_float(rr[1])); } \
      resc = false; \
      if (__builtin_expect(__any(rm > (float)THRL), 0)) { const float dl = __builtin_fmaxf(rm, 0.f); mhat += dl; \
        _Pragma("unroll") for (int r = 0; r < 16; ++r) { C0[r] -= dl; C1[r] -= dl; } \
        _Pragma("unroll") for (int r = 0; r < 16; ++r) negm[r] = -mhat; asm volatile("" : "+v"(negm)); \
        const float f = __builtin_amdgcn_exp2f(-dl); l_reg *= f; if (hi == 0) wsf[r32] = f; resc = true; } } \
    SBAR(); \
    GAPB(o[0] = MF16(PAF(0), VFR(0), o[0], 0, 0, 0), C0, 0); \
    GAPB(o[1] = MF16(PAF(0), VFR(4), o[1], 0, 0, 0), C0, 4); \
    KRD(GL, 0, t); GAPB(o[0] = MF16(PAF(1), VFR(1), o[0], 0, 0, 0), C0, 8); \
    KRD(GL, 1, t); GAPB(o[1] = MF16(PAF(1), VFR(5), o[1], 0, 0, 0), C0, 12); \
    KRD(GL, 2, t); GAPB(o[0] = MF16(PAF(2), VFR(2), o[0], 0, 0, 0), C1, 0); \
    KRD(GL, 3, t); GAPB(o[1] = MF16(PAF(2), VFR(6), o[1], 0, 0, 0), C1, 4); \
    GAPB(o[0] = MF16(PAF(3), VFR(3), o[0], 0, 0, 0), C1, 8); \
    GAPB(o[1] = MF16(PAF(3), VFR(7), o[1], 0, 0, 0), C1, 12); \
    } while (0)
    int t = 1;
#undef CMASK
#define CMASK(P0, P1, t) do { if (MOBA) past_mask_far(P0, P1, (t), selmask, c31); } while (0)
    for (; t + 7 < NT; t += 2) {
        STEP(pB0, pB1, pA0, pA1, t, true, true, true);     WAIT_BAR(3); RESC(); ROT();
        STEP(pA0, pA1, pB0, pB1, t + 1, true, true, true); WAIT_BAR(3); RESC(); ROT();
    }
#undef CMASK
#define CMASK(P0, P1, t) do { if (MOBA) { const int jb_ = (t) - (NT - 4); if (jb_ >= 0) band_mask(P0, P1, jb_, qrel, hi, lutw); else past_mask(P0, P1, (t), qt, wid, r32, hi, selmask, c31, lutw); } } while (0)
#define ENDW(tt) do { if ((tt) + 3 < NT) { WAIT_BAR(3); } else if ((tt) + 2 < NT) { WAIT_BAR(2); } else { WAIT_BAR(0); } } while (0)
    for (; t + 1 < NT; t += 2) {
        STEP(pB0, pB1, pA0, pA1, t, (t + 3 < NT), (t + 2 < NT), (t + 1 < NT));     ENDW(t);     RESC(); ROT();
        STEP(pA0, pA1, pB0, pB1, t + 1, (t + 4 < NT), (t + 3 < NT), (t + 2 < NT)); ENDW(t + 1); RESC(); ROT();
    }
    STEP(pB0, pB1, pA0, pA1, NT - 1, false, false, false); RESC();
    if (nextQ) {
        const half_t* nq = nextQ + (size_t)(wid * 32 + r32) * nextQP + hi * 8;
#pragma unroll
        for (int d0 = 0; d0 < 4; ++d0) qr[d0] = *(const h8*)(nq + d0 * 16);
    }
    h8 zv[4];
    { const half_t* zp = Zg + (size_t)(wid * 32 + (lane >> 1)) * PP + (lane & 1) * 32;
#pragma unroll
      for (int c = 0; c < 4; ++c) zv[c] = *(const h8*)(zp + c * 8); }
    { float sacc = pB0[0] + pB0[1]; _Pragma("unroll") for (int r = 2; r < 16; ++r) sacc += pB0[r]; _Pragma("unroll") for (int r = 0; r < 16; ++r) sacc += pB1[r]; l_reg += sacc;
      pw0 = (u32x4){PKW(pB0, 0), PKW(pB0, 2), PKW(pB0, 4), PKW(pB0, 6)}; pw1 = (u32x4){PKW(pB0, 8), PKW(pB0, 10), PKW(pB0, 12), PKW(pB0, 14)}; pw2 = (u32x4){PKW(pB1, 0), PKW(pB1, 2), PKW(pB1, 4), PKW(pB1, 6)}; pw3 = (u32x4){PKW(pB1, 8), PKW(pB1, 10), PKW(pB1, 12), PKW(pB1, 14)};
      SBAR(); pv(o, vb0 + ((NT - 1) & 3) * SLOTB, PAF(0), PAF(1), PAF(2), PAF(3)); }
#undef PKW
#undef PAF
#undef VFR
#undef PIN
#undef MX3
#undef GAPA
#undef GAPB
#undef EX
#undef VRD
#undef KRD
#undef MF16
#undef STEP
#undef ENDW
    { auto rr = __builtin_amdgcn_permlane32_swap(__float_as_uint(l_reg), __float_as_uint(l_reg), false, false); l_reg = __uint_as_float(rr[0]) + __uint_as_float(rr[1]); }
    if (hi == 0) wsf[32 + r32] = __builtin_amdgcn_rcpf(l_reg);
    LAS float* stg = (LAS float*)(shm + LDS_STG + wid * STG_W);
#pragma unroll
    for (int r = 0; r < 16; ++r) { const int q = crow(r, hi); stg[q * STG_ROW + r32] = o[0][r]; stg[q * STG_ROW + 32 + r32] = o[1][r]; }
    asm volatile("s_waitcnt lgkmcnt(0)" ::: "memory");
    { const int row = lane >> 1, hf = lane & 1; const LAS float* sp = stg + row * STG_ROW + hf * 32; const float inv = wsf[32 + row];
      half_t* yp = Yg + (size_t)(wid * 32 + row) * DM + hf * 32; float ss = 0.f; f32x2 ss2 = {0.f, 0.f};
#pragma unroll
      for (int c = 0; c < 4; ++c) { const f32x4 v0 = *(const LAS f32x4*)(sp + c * 8) * inv, v1 = *(const LAS f32x4*)(sp + c * 8 + 4) * inv; const h8 z = zv[c];
          ss2 = (f32x2){v0[0], v0[1]} * (f32x2){v0[0], v0[1]} + ss2; ss2 = (f32x2){v0[2], v0[3]} * (f32x2){v0[2], v0[3]} + ss2;
          ss2 = (f32x2){v1[0], v1[1]} * (f32x2){v1[0], v1[1]} + ss2; ss2 = (f32x2){v1[2], v1[3]} * (f32x2){v1[2], v1[3]} + ss2;
          u32x4 w; w.x = pkh(v0[0] * (float)z[0], v0[1] * (float)z[1]); w.y = pkh(v0[2] * (float)z[2], v0[3] * (float)z[3]);
          w.z = pkh(v1[0] * (float)z[4], v1[1] * (float)z[5]); w.w = pkh(v1[2] * (float)z[6], v1[3] * (float)z[7]);
          *(u32x4*)(yp + c * 8) = w; }
      ss = ss2.x + ss2.y;
      ss += __shfl_xor(ss, 1);
      if (hf == 0) ssyp[(size_t)(wid * 32 + row) * 16] = ss; }
    asm volatile("s_waitcnt lgkmcnt(0)\n\ts_barrier" ::: "memory");
#undef DMA_K
#undef DMA_V
#undef CMASK
#undef START
#undef RESC
#undef ROT
}
#undef SBAR
#undef WAIT_BAR
}

__device__ __forceinline__ void gmlp_unit(LAS unsigned char* lds, int tid, const half_t* proj, const half_t* wsp_lg, const float* lng, const float* lnb, const float* spb, half_t* Y, float* ssy, int bc2, int g) {
    asm volatile("" : "+v"(tid));
    const int lane = tid & 63, wid = __builtin_amdgcn_readfirstlane(tid >> 6);
    const int r0 = bc2 * 256;
    const int s = tid >> 2, qd = tid & 3;
    const int tl = lane >> 2, cq = lane & 3, t = 16 * wid + tl;
    h8 vv[2][2], uu[2][2], zz[2][2];
#pragma unroll
    for (int c = 0; c < 2; ++c) { const half_t* vp = proj + (size_t)(r0 + c * 128 + s) * PP + C_V + g * 64 + qd * 16; vv[c][0] = *(const h8*)vp; vv[c][1] = *(const h8*)(vp + 8); }
#pragma unroll
    for (int c = 0; c < 2; ++c) { const half_t* up = proj + (size_t)(r0 + c * 128 + t) * PP + C_U + g * 64 + cq * 16; const half_t* zp = proj + (size_t)(r0 + c * 128 + t) * PP + C_Z + g * 64 + cq * 16;
        uu[c][0] = *(const h8*)up; uu[c][1] = *(const h8*)(up + 8); zz[c][0] = *(const h8*)zp; zz[c][1] = *(const h8*)(zp + 8); }
    float lg[16], lb[16];
#pragma unroll
    for (int e = 0; e < 16; ++e) { lg[e] = lng[qd * 16 + e]; lb[e] = lnb[qd * 16 + e]; }
    const int r16 = lane & 15, kq = lane >> 4;
    const int nks = (16 * wid + 15) / 32 + 1;
    h8 af[4];
#pragma unroll
    for (int ks = 0; ks < 4; ++ks) af[ks] = *(const h8*)(wsp_lg + (size_t)(16 * wid + r16) * 128 + (ks < nks ? ks : 0) * 32 + kq * 8);
    const float bsp = spb[t];
#pragma unroll
    for (int c = 0; c < 2; ++c) {
        LAS half_t* vnt = (LAS half_t*)(lds + GM_VNT + c * GM_VNT_BYTES);
        float x[16]; float sum = 0.f;
#pragma unroll
        for (int e = 0; e < 8; ++e) { x[e] = (float)vv[c][0][e]; x[8 + e] = (float)vv[c][1][e]; }
#pragma unroll
        for (int e = 0; e < 16; ++e) sum += x[e];
        sum += __shfl_xor(sum, 1); sum += __shfl_xor(sum, 2);
        const float mu = sum * (1.0f / 64.0f); float var = 0.f;
#pragma unroll
        for (int e = 0; e < 16; ++e) { x[e] -= mu; var += x[e] * x[e]; }
        var += __shfl_xor(var, 1); var += __shfl_xor(var, 2);
        const float rs = __builtin_amdgcn_rsqf(var * (1.0f / 64.0f) + EPS);
#pragma unroll
        for (int e = 0; e < 16; ++e) vnt[(qd * 16 + e) * GM_VNT_ROW + s] = (half_t)(x[e] * rs * lg[e] + lb[e]);
    }
    __syncthreads();
    f32x4 acc[2][4];
#pragma unroll
    for (int c = 0; c < 2; ++c)
#pragma unroll
        for (int n = 0; n < 4; ++n) acc[c][n] = (f32x4){0.f, 0.f, 0.f, 0.f};
#pragma unroll
    for (int ks = 0; ks < 4; ++ks) {
        if (ks < nks) {
#pragma unroll
            for (int c = 0; c < 2; ++c)
#pragma unroll
                for (int n = 0; n < 4; ++n) { const h8 bf = *(const LAS h8*)(lds + GM_VNT + c * GM_VNT_BYTES + ((16 * n + r16) * GM_VNT_ROW + ks * 32 + kq * 8) * 2);
                    acc[c][n] = __builtin_amdgcn_mfma_f32_16x16x32_f16(af[ks], bf, acc[c][n], 0, 0, 0); }
        }
    }
#pragma unroll
    for (int c = 0; c < 2; ++c) {
        LAS float* stg = (LAS float*)(lds + GM_STAGE) + (c * 8 + wid) * 16 * AT_STG_ROW;
#pragma unroll
        for (int n = 0; n < 4; ++n)
#pragma unroll
            for (int e = 0; e < 4; ++e) stg[(4 * kq + e) * AT_STG_ROW + 16 * n + r16] = acc[c][n][e];
    }
    asm volatile("s_waitcnt lgkmcnt(0)" ::: "memory");
#pragma unroll
    for (int c = 0; c < 2; ++c) {
        const LAS float* sp = (const LAS float*)(lds + GM_STAGE) + (c * 8 + wid) * 16 * AT_STG_ROW + tl * AT_STG_ROW + cq * 16;
        const int row = r0 + c * 128 + t; half_t* yp = Y + (size_t)row * DM + g * 64 + cq * 16; float ss = 0.f;
#pragma unroll
        for (int k = 0; k < 2; ++k) { const f32x4 s0 = *(const LAS f32x4*)(sp + k * 8), s1 = *(const LAS f32x4*)(sp + k * 8 + 4); const h8 u = uu[c][k], z = zz[c][k]; float yv[8];
#pragma unroll
            for (int e = 0; e < 4; ++e) { yv[e] = (float)u[e] * (s0[e] + bsp); yv[4 + e] = (float)u[4 + e] * (s1[e] + bsp); }
#pragma unroll
            for (int e = 0; e < 8; ++e) ss += yv[e] * yv[e];
            u32x4 w; w.x = pkh(yv[0] * (float)z[0], yv[1] * (float)z[1]); w.y = pkh(yv[2] * (float)z[2], yv[3] * (float)z[3]);
            w.z = pkh(yv[4] * (float)z[4], yv[5] * (float)z[5]); w.w = pkh(yv[6] * (float)z[6], yv[7] * (float)z[7]);
            *(u32x4*)(yp + k * 8) = w; }
        ss += __shfl_xor(ss, 1); ss += __shfl_xor(ss, 2);
        if (cq == 0) ssy[(size_t)row * 16 + g] = ss;
    }
    __syncthreads();
}

__device__ __forceinline__ void gmlp_chain3(LAS unsigned char* lds, int tid, const half_t* proj, const half_t* wsp_l, const float* lng_l, const float* lnb_l, const float* spb_l, half_t* Y, float* ssy, int grp, int rank) {
    asm volatile("" : "+v"(tid));
    const int lane = tid & 63, wid = __builtin_amdgcn_readfirstlane(tid >> 6);
    const int s = tid >> 2, qd = tid & 3;
    const int tl = lane >> 2, cq = lane & 3, t = 16 * wid + tl;
    const int r16 = lane & 15, kq = lane >> 4;
    const int nks = (16 * wid + 15) / 32 + 1;
    h8 vv[2][2], uu[2][2], zz[2][2], af[4], afn[4]; float lg[16], lb[16]; float bsp;
#define GM_UNIT(k) const int ug_ = rank * 3 + (k), g_ = ug_ >> 4, r0_ = (16 * grp + (ug_ & 15)) * 256
#define GM_LOADV(k, AF) do { GM_UNIT(k); \
        _Pragma("unroll") for (int c = 0; c < 2; ++c) { const half_t* vp = proj + (size_t)(r0_ + c * 128 + s) * PP + C_V + g_ * 64 + qd * 16; vv[c][0] = *(const h8*)vp; vv[c][1] = *(const h8*)(vp + 8); } \
        _Pragma("unroll") for (int e = 0; e < 16; ++e) { lg[e] = lng_l[g_ * 64 + qd * 16 + e]; lb[e] = lnb_l[g_ * 64 + qd * 16 + e]; } \
        _Pragma("unroll") for (int ks = 0; ks < 4; ++ks) AF[ks] = *(const h8*)(wsp_l + (size_t)g_ * 128 * 128 + (size_t)(16 * wid + r16) * 128 + (ks < nks ? ks : 0) * 32 + kq * 8); } while (0)
#define GM_LOADUZ(k) do { GM_UNIT(k); \
        _Pragma("unroll") for (int c = 0; c < 2; ++c) { const half_t* up = proj + (size_t)(r0_ + c * 128 + t) * PP + C_U + g_ * 64 + cq * 16; const half_t* zp = proj + (size_t)(r0_ + c * 128 + t) * PP + C_Z + g_ * 64 + cq * 16; \
            uu[c][0] = *(const h8*)up; uu[c][1] = *(const h8*)(up + 8); zz[c][0] = *(const h8*)zp; zz[c][1] = *(const h8*)(zp + 8); } \
        bsp = spb_l[g_ * 128 + t]; } while (0)
    GM_LOADV(0, af); GM_LOADUZ(0);
#pragma unroll
    for (int k = 0; k < 3; ++k) {
        GM_UNIT(k);
#pragma unroll
        for (int c = 0; c < 2; ++c) {
            LAS half_t* vnt = (LAS half_t*)(lds + GM_VNT + c * GM_VNT_BYTES);
            float x[16]; float sum = 0.f;
#pragma unroll
            for (int e = 0; e < 8; ++e) { x[e] = (float)vv[c][0][e]; x[8 + e] = (float)vv[c][1][e]; }
#pragma unroll
            for (int e = 0; e < 16; ++e) sum += x[e];
            sum += __shfl_xor(sum, 1); sum += __shfl_xor(sum, 2);
            const float mu = sum * (1.0f / 64.0f); float var = 0.f;
#pragma unroll
            for (int e = 0; e < 16; ++e) { x[e] -= mu; var += x[e] * x[e]; }
            var += __shfl_xor(var, 1); var += __shfl_xor(var, 2);
            const float rs = __builtin_amdgcn_rsqf(var * (1.0f / 64.0f) + EPS);
#pragma unroll
            for (int e = 0; e < 16; ++e) vnt[(qd * 16 + e) * GM_VNT_ROW + s] = (half_t)(x[e] * rs * lg[e] + lb[e]);
        }
        __syncthreads();
        if (k < 2) GM_LOADV(k + 1, afn);
        f32x4 acc[2][4];
#pragma unroll
        for (int c = 0; c < 2; ++c)
#pragma unroll
            for (int n = 0; n < 4; ++n) acc[c][n] = (f32x4){0.f, 0.f, 0.f, 0.f};
#pragma unroll
        for (int ks = 0; ks < 4; ++ks) {
            if (ks < nks) {
#pragma unroll
                for (int c = 0; c < 2; ++c)
#pragma unroll
                    for (int n = 0; n < 4; ++n) { const h8 bf = *(const LAS h8*)(lds + GM_VNT + c * GM_VNT_BYTES + ((16 * n + r16) * GM_VNT_ROW + ks * 32 + kq * 8) * 2);
                        acc[c][n] = __builtin_amdgcn_mfma_f32_16x16x32_f16(af[ks], bf, acc[c][n], 0, 0, 0); }
            }
        }
#pragma unroll
        for (int c = 0; c < 2; ++c) {
            LAS float* stg = (LAS float*)(lds + GM_STAGE) + (c * 8 + wid) * 16 * AT_STG_ROW;
#pragma unroll
            for (int n = 0; n < 4; ++n)
#pragma unroll
                for (int e = 0; e < 4; ++e) stg[(4 * kq + e) * AT_STG_ROW + 16 * n + r16] = acc[c][n][e];
        }
        asm volatile("s_waitcnt lgkmcnt(0)" ::: "memory");
#pragma unroll
        for (int c = 0; c < 2; ++c) {
            const LAS float* sp = (const LAS float*)(lds + GM_STAGE) + (c * 8 + wid) * 16 * AT_STG_ROW + tl * AT_STG_ROW + cq * 16;
            const int row = r0_ + c * 128 + t; half_t* yp = Y + (size_t)row * DM + g_ * 64 + cq * 16; float ss = 0.f;
#pragma unroll
            for (int j = 0; j < 2; ++j) { const f32x4 s0 = *(const LAS f32x4*)(sp + j * 8), s1 = *(const LAS f32x4*)(sp + j * 8 + 4); const h8 u = uu[c][j], z = zz[c][j]; float yv[8];
#pragma unroll
                for (int e = 0; e < 4; ++e) { yv[e] = (float)u[e] * (s0[e] + bsp); yv[4 + e] = (float)u[4 + e] * (s1[e] + bsp); }
#pragma unroll
                for (int e = 0; e < 8; ++e) ss += yv[e] * yv[e];
                u32x4 w; w.x = pkh(yv[0] * (float)z[0], yv[1] * (float)z[1]); w.y = pkh(yv[2] * (float)z[2], yv[3] * (float)z[3]);
                w.z = pkh(yv[4] * (float)z[4], yv[5] * (float)z[5]); w.w = pkh(yv[6] * (float)z[6], yv[7] * (float)z[7]);
                *(u32x4*)(yp + j * 8) = w; }
            ss += __shfl_xor(ss, 1); ss += __shfl_xor(ss, 2);
            if (cq == 0) ssy[(size_t)row * 16 + g_] = ss;
        }
        if (k < 2) { GM_LOADUZ(k + 1);
#pragma unroll
            for (int ks = 0; ks < 4; ++ks) af[ks] = afn[ks]; }
        __syncthreads();
    }
#undef GM_UNIT
#undef GM_LOADV
#undef GM_LOADUZ
}

constexpr int NU_MOBA = 96 * 8, NU_MEM = 64 * 8, NU_GMLP = 128 * 6, NU_ALL = NU_MOBA + NU_MEM + NU_GMLP;
__device__ __forceinline__ void mixer_phase_fast(Frame& F, const Args& a, int l, int qidx) {
    static_assert(fa::LDS_END <= MISC_OFF, "attention LDS map");
    LAS float* lut = (LAS float*)(F.lds + fa::LDS_LUT);
    { const f32x4* src = (const f32x4*)(a.ws + WS_LUT); static_assert(fa::LUT_N == 768, "table size");
      for (int i = F.tid; i < 6 * fa::LUT_N / 4; i += NTHR) ((LAS f32x4*)lut)[i] = src[i]; }
    __syncthreads();
    volatile LAS unsigned* MISC = (volatile LAS unsigned*)(F.lds + MISC_OFF);
    const bool deal = F.G == 256;
    const int grp = F.bid & 7;
    unsigned* qhead = F.ctl + CW_QUEUE + 64 * (deal ? qidx * 8 + grp : 24 + qidx);
    const half_t* mkv_l = F.mkv + (size_t)l * MMEM * NKV;
    const int vcu = (F.bid & 7) * 32 + (F.bid >> 3);
    h8 qr[4] = {};
    for (int it = 0;; ++it) {
        int u;
        if (deal && it < 5) {
            if (it < 3) { const int gi = vcu >> 3, tri = vcu & 7; int bsel, qt;
                if (tri < 6) { bsel = tri >> 1; qt = (tri & 1) ? (it == 0 ? 6 : (it == 1 ? 5 : 0)) : (it == 0 ? 7 : (it == 1 ? 2 : 1)); }
                else if (tri == 6) { bsel = it == 1 ? 1 : 0; qt = it == 2 ? 3 : 4; }
                else { bsel = it == 1 ? 1 : 2; qt = it == 0 ? 4 : 3; }
                u = (7 - qt) * 96 + 3 * gi + bsel; }
            else u = NU_MOBA + (vcu >> 2) * 8 + 2 * (vcu & 3) + (it - 3);
        } else if (deal) {
            gmlp_chain3(F.lds, F.tid, F.proj, F.wsp + (size_t)l * 6 * 128 * 128, a.ln_g + l * 384, a.ln_b + l * 384, a.sp_b + l * 6 * 128, F.y, F.ssy, grp, vcu & 31);
            break;
        } else {
            if (F.tid == 0) MISC[16] = __hip_atomic_fetch_add(qhead, 1u, __ATOMIC_RELAXED, __HIP_MEMORY_SCOPE_AGENT);
            __syncthreads();
            u = __builtin_amdgcn_readfirstlane((int)MISC[16]);
            if (u >= NU_ALL) break;
        }
        if (u < NU_MOBA) {
            const int qt = 7 - u / 96, bh = u % 96, b = bh / 6, h = bh % 6; const size_t row0 = (size_t)b * SEQ + qt * 256;
            fa::attn_unit<true, 8>(F.lds, F.proj + row0 * PP + C_QB + h * 64, PP, F.proj + (size_t)b * SEQ * PP + C_KB + h * 64, F.proj + (size_t)b * SEQ * PP + C_VB + h * 64, PP, 4 * qt + 4, qt,
                                   F.kmean + (size_t)(b * 8) * 384 + h * 64, lut + h * fa::LUT_N, F.y + row0 * DM + 384 + h * 64, F.proj + row0 * PP + C_Z + 384 + h * 64, F.ssy + row0 * 16 + 6 + h, qr, false, false, nullptr, 0);
        } else if (u < NU_MOBA + NU_MEM) {
            const int v = u - NU_MOBA, b = v >> 5, h = (v >> 3) & 3, qt = v & 7; const size_t row0 = (size_t)b * SEQ + qt * 256;
            const bool pair1 = deal && it == 3, pair2 = deal && it == 4;
            fa::attn_unit<false, 8>(F.lds, F.proj + row0 * PP + C_QM + h * 64, PP, mkv_l + (size_t)b * MEML * NKV + h * 64, mkv_l + (size_t)b * MEML * NKV + 256 + h * 64, NKV, 4, 0,
                                    nullptr, lut, F.y + row0 * DM + 768 + h * 64, F.proj + row0 * PP + C_Z + 768 + h * 64, F.ssy + row0 * 16 + 12 + h,
                                    qr, pair2, pair2, pair1 ? F.proj + (row0 + 256) * PP + C_QM + h * 64 : nullptr, PP);
        } else {
            const int v = u - NU_MOBA - NU_MEM, g = v >> 7, bc = v & 127;
            gmlp_unit(F.lds, F.tid, F.proj, F.wsp + (size_t)(l * 6 + g) * 128 * 128, a.ln_g + l * 384 + g * 64, a.ln_b + l * 384 + g * 64, a.sp_b + (l * 6 + g) * 128, F.y, F.ssy, bc, g);
        }
    }
}

__device__ __forceinline__ void ynorm_phase(Frame& F) {
    const int gw = F.bid * NWAVES + F.wave, NGW = F.G * NWAVES;
    for (int m = gw; m < MTOK; m += NGW) {
        const float* sp = F.ssy + (size_t)m * 16;
        const int br = F.lane < 24 ? 0 : (F.lane < 48 ? 1 : 2);
        float s = 0.f;
        if (br == 0) s = ((sp[0] + sp[1]) + (sp[2] + sp[3])) + (sp[4] + sp[5]);
        else if (br == 1) s = ((sp[6] + sp[7]) + (sp[8] + sp[9])) + (sp[10] + sp[11]);
        else s = (sp[12] + sp[13]) + (sp[14] + sp[15]);
        const float rs = __builtin_amdgcn_rsqf(s * (br == 2 ? 1.0f / 256.0f : 1.0f / 384.0f) + EPS);
        h8* yp = (h8*)(F.y + (size_t)m * DM + F.lane * 16);
#pragma unroll
        for (int c = 0; c < 2; ++c) { h8 v = yp[c];
#pragma unroll
            for (int e = 0; e < 8; ++e) v[e] = (half_t)((float)v[e] * rs);
            yp[c] = v; }
    }
}
__device__ __forceinline__ void final_phase(Frame& F, const Args& a, float* dst) {
    const bool deal = (F.G & 7) == 0;
    const int gw = deal ? (F.bid >> 3) * NWAVES + F.wave : F.bid * NWAVES + F.wave, NGW = deal ? (F.G >> 3) * NWAVES : F.G * NWAVES;
    const int rbase = deal ? (F.bid & 7) * (MTOK / 8) : 0, rend = deal ? rbase + MTOK / 8 : MTOK;
    const float* ss2 = F.ssx + 2 * MTOK;
    const f32x4* gp = (const f32x4*)a.fin_g + 2 * F.lane; f32x4 g[2][2];
#pragma unroll
    for (int j = 0; j < 2; ++j) { g[j][0] = gp[128 * j]; g[j][1] = gp[128 * j + 1]; }
    for (int m0 = rbase + gw * 8; m0 < rend; m0 += NGW * 8) {
        h8 v[8][2]; float rs[8];
#pragma unroll
        for (int i = 0; i < 8; ++i) { const h8* xp = (const h8*)(F.xh + (size_t)(m0 + i) * DM) + F.lane; rs[i] = ss2[m0 + i]; v[i][0] = __builtin_nontemporal_load(xp); v[i][1] = __builtin_nontemporal_load(xp + 64); }
#pragma unroll
        for (int i = 0; i < 8; ++i) { f32x4* op = (f32x4*)(dst + (size_t)(m0 + i) * DM) + 2 * F.lane; const float r = __builtin_amdgcn_rsqf(rs[i] * (1.0f / DM) + EPS);
#pragma unroll
            for (int j = 0; j < 2; ++j) { const h8 x = v[i][j];
                __builtin_nontemporal_store((f32x4){(float)x[0], (float)x[1], (float)x[2], (float)x[3]} * r * g[j][0], op + 128 * j);
                __builtin_nontemporal_store((f32x4){(float)x[4], (float)x[5], (float)x[6], (float)x[7]} * r * g[j][1], op + 128 * j + 1); } }
    }
}

#define MIXER_PHASE mixer_phase_fast
constexpr int N_PHASES = 8;
__global__ void __launch_bounds__(NTHR, 2) fwd_kernel(Args a_unused) {
    extern __shared__ __attribute__((aligned(16))) unsigned char lds_raw[];
    LAS unsigned char* lds = (LAS unsigned char*)lds_raw;
    volatile LAS unsigned* MISC = (volatile LAS unsigned*)(lds + MISC_OFF);
    for (int u = threadIdx.x; u < 64; u += NTHR) MISC[u] = 0u;
    __syncthreads();
    if (blockIdx.x < 8u) {
        unsigned long long pc; asm volatile("s_getpc_b64 %0" : "=s"(pc));
        const u32x4* cp = (const u32x4*)(pc & ~0xFFull) + threadIdx.x; unsigned acc = 0u;
#pragma unroll
        for (int i = 0; i < 14; ++i) { const u32x4 v = cp[i * NTHR]; acc ^= v.x ^ v.y ^ v.z ^ v.w; }
        if (acc == 0x9E3779B9u) MISC[30] = acc;
    }
    XcdBarrier bar; GrpBarrier gbar;
    { const Args a = load_args(); bar = xcd_barrier_post((unsigned*)(a.ws + WS_CTL) + CW_BAR, MISC + 8); gbar = grp_barrier_post((unsigned*)(a.ws + WS_CTL), MISC + 10); }
    const bool fusefin = gridDim.x == 256u;
    const bool grouped = (gridDim.x & 7u) == 0u;
#define IN(k) (kargs()->ph_lo <= (k) && (k) < kargs()->ph_hi)
#define SEAM(k) do { if (IN(k) && IN((k) + 1)) { if ((k) > 0 && grouped) grp_barrier(gbar); else xcd_barrier(bar); } } while (0)
    if (IN(0)) { const Args a = load_args(); Frame F = make_frame(lds, a); p0_prologue(F, a);
    } SEAM(0);
    for (int l = 0; l < 2; ++l) {
        const int pb = 3 * l;
        if (IN(pb + 1)) {
            const Args a = load_args(); Frame F = make_frame(lds, a);
            pg8::Gemm g{F.xh, F.bt1 + (size_t)l * NB1 * DM, DM, nullptr}; pg8::Order1 S{F.G, F.bid};
            pg8::EpiProj E{F.proj, F.mkv + (size_t)l * MMEM * NKV, F.ssx + (size_t)l * MTOK, F.kmean + (size_t)l * 128 * 384};
            pg8::gemm_phase<pg8::EpiProj, pg8::Order1, false>(lds, g, S, E);
        } SEAM(pb + 1);
        if (IN(pb + 2)) { const Args a = load_args(); Frame F = make_frame(lds, a); F.kmean += (size_t)l * 128 * 384; MIXER_PHASE(F, a, l, l);
        } SEAM(pb + 2);
        if (IN(pb + 3)) {
            const Args a = load_args(); Frame F = make_frame(lds, a);
            pg8::Gemm g{F.y, F.bt2 + (size_t)l * DM * DM, DM, F.ssy}; pg8::Order2 S{F.G, F.bid};
            if (l == 1 && fusefin) {
                pg8::EpiFinal E{F.xh, a.out, F.ssx + 2 * MTOK, a.fin_g, F.ctl + CW_PANEL, F.ctl + CW_BAR + XB_TMO};
                pg8::gemm_phase<pg8::EpiFinal, pg8::Order2, true>(lds, g, S, E);
            } else {
                pg8::EpiResid E{F.xh, F.xh, F.ssx + (size_t)(l + 1) * MTOK};
                pg8::gemm_phase<pg8::EpiResid, pg8::Order2, true>(lds, g, S, E);
            }
        } if (!(l == 1 && fusefin)) SEAM(pb + 3);
    }
    if (IN(7) && !fusefin) { const Args a = load_args(); Frame F = make_frame(lds, a);
        final_phase(F, a, a.out); }
#undef IN
#undef SEAM
}

#ifndef MK_PER_PHASE
#define MK_PER_PHASE 0
#endif
extern "C" void kernel_launch(void* const* d_in, const int* in_sizes, int n_in, void* d_out, int out_size, void* d_ws, size_t ws_size, hipStream_t stream) {
    static int grid = 0;
    if (grid == 0) {
        if (n_in != 14 || in_sizes[0] != MTOK * DM || out_size != MTOK * DM || ws_size < WS_END) { fprintf(stderr, "kernel_launch: unexpected shapes (n_in %d, in0 %d, out %d, ws %zu)\n", n_in, n_in > 0 ? in_sizes[0] : -1, out_size, ws_size); grid = -1; return; }
        int dev = 0, cus = 0, per_cu = 0;
        if (hipGetDevice(&dev) != hipSuccess || hipDeviceGetAttribute(&cus, hipDeviceAttributeMultiprocessorCount, dev) != hipSuccess) { grid = -1; return; }
        if (hipFuncSetAttribute((const void*)fwd_kernel, hipFuncAttributeMaxDynamicSharedMemorySize, LDS_BYTES) != hipSuccess) { fprintf(stderr, "kernel_launch: hipFuncSetAttribute failed\n"); grid = -1; return; }
        if (hipOccupancyMaxActiveBlocksPerMultiprocessor(&per_cu, (const void*)fwd_kernel, NTHR, LDS_BYTES) != hipSuccess || per_cu < 1) { fprintf(stderr, "kernel_launch: occupancy query says %d\n", per_cu); }
        (void)hipGetLastError();
        grid = cus;
    }
    if (grid < 0) return;
    (void)hipMemsetAsync((char*)d_ws + WS_CTL, 0, CTL_ZERO_BYTES, stream);
    Args a{};
    a.x = (const float*)d_in[0]; a.mem = (const float*)d_in[1]; a.norm_g = (const float*)d_in[2]; a.w_in = (const float*)d_in[3]; a.ln_g = (const float*)d_in[4]; a.ln_b = (const float*)d_in[5];
    a.sp_w = (const float*)d_in[6]; a.sp_b = (const float*)d_in[7]; a.rel_bias = (const float*)d_in[8]; a.mem_norm_g = (const float*)d_in[9]; a.w_kv = (const float*)d_in[10];
    a.br_g = (const float*)d_in[11]; a.w_out = (const float*)d_in[12]; a.fin_g = (const float*)d_in[13];
    a.out = (float*)d_out; a.ws = (unsigned char*)d_ws;
#if MK_PER_PHASE
    for (int p = 0; p < N_PHASES; ++p) { a.ph_lo = p; a.ph_hi = p + 1; hipLaunchKernelGGL(fwd_kernel, dim3(grid), dim3(NTHR), LDS_BYTES, stream, a); }
#else
    a.ph_lo = 0; a.ph_hi = N_PHASES; hipLaunchKernelGGL(fwd_kernel, dim3(grid), dim3(NTHR), LDS_BYTES, stream, a);
#endif
}
```
